# Optimizing an MI355X kernel written in HIP

```python
import jax
import jax.numpy as jnp
from jax import lax
import numpy as np

D_MODEL = 2048
BATCH = 4
SEQ = 2048
DEPTH = 2

CHUNK = 64
GROUP_WIDTH = D_MODEL // 4
MLSTM_HEADS = 4
MLSTM_HEAD_DIM = GROUP_WIDTH // MLSTM_HEADS
MLSTM_CONV = 4
FORGET_BIAS = 3.0
POOL_WINDOWS = (2, 4, 8, 16)
POOL_GROUPS = len(POOL_WINDOWS)
POOL_GROUP_DIM = GROUP_WIDTH // POOL_GROUPS
SB_HEADS = 4
SB_HEAD_DIM = GROUP_WIDTH // SB_HEADS
SB_BLOCK = 128
CONV_WIDTH = 31
IN_SPLITS = (2 * GROUP_WIDTH, GROUP_WIDTH, GROUP_WIDTH, 2 * MLSTM_HEADS,
             GROUP_WIDTH, 3 * GROUP_WIDTH, 2 * GROUP_WIDTH)
IN_COLS = sum(IN_SPLITS)
D_FF = 5632
N_EXPERTS = 8
TOP_K = 2
D_FF_EXPERT = D_FF // TOP_K
N_DENSE = (DEPTH + 1) // 2
N_MOE = DEPTH // 2
ALPHA = (2.0 * DEPTH) ** 0.25
BETA = (8.0 * DEPTH) ** -0.25
EPS = 1e-5

kernel_name = "hybrid_streaming_encoder_mlstm_pool_stickbreak_conformer_moe"


def _layer_norm(x, w, b):
    xf = x.astype(jnp.float32)
    mu = jnp.mean(xf, axis=-1, keepdims=True)
    var = jnp.mean(jnp.square(xf - mu), axis=-1, keepdims=True)
    return ((xf - mu) * lax.rsqrt(var + EPS)).astype(x.dtype) * w + b


def _rms_norm(x, w):
    xf = x.astype(jnp.float32)
    return (xf * lax.rsqrt(jnp.mean(jnp.square(xf), axis=-1, keepdims=True) + EPS)).astype(x.dtype) * w


def _causal_depthwise_conv(x, w, b):
    k = w.shape[0]
    y = lax.conv_general_dilated(x, w[:, None, :], window_strides=(1,), padding=((k - 1, 0),),
                                 dimension_numbers=("NWC", "WIO", "NWC"),
                                 feature_group_count=x.shape[-1])
    return y + b


def _mlstm_chunkwise(q, k, v, i_pre, f_pre):
    B_, H, S, d = q.shape
    nc = S // CHUNK
    f32 = jnp.float32

    def chunks(t):
        return jnp.moveaxis(t.reshape(B_, H, nc, CHUNK, *t.shape[3:]), 2, 0)

    qc = chunks(q.astype(f32) * (d ** -0.5))
    kc = chunks(k.astype(f32))
    vc = chunks(v.astype(f32))
    ic = chunks(i_pre.astype(f32))
    bc = jnp.cumsum(chunks(jax.nn.log_sigmoid(f_pre.astype(f32))), axis=-1)
    causal = jnp.tril(jnp.ones((CHUNK, CHUNK), dtype=bool))

    def step(carry, xs):
        C, n, m = carry
        q_, k_, v_, i_, b_ = xs
        g = b_[..., -1]
        log_d = jnp.where(causal, b_[..., :, None] - b_[..., None, :] + i_[..., None, :], -jnp.inf)
        m_inter = b_ + m[..., None]
        m_t = jnp.maximum(m_inter, jnp.max(log_d, axis=-1))
        w = jnp.exp(log_d - m_t[..., None]) * jnp.einsum("bhtd,bhsd->bhts", q_, k_)
        inter = jnp.exp(m_inter - m_t)
        num = inter[..., None] * jnp.einsum("bhtd,bhde->bhte", q_, C) + jnp.einsum("bhts,bhse->bhte", w, v_)
        den = inter * jnp.einsum("bhtd,bhd->bht", q_, n) + jnp.sum(w, axis=-1)
        h = num / jnp.maximum(jnp.abs(den), jnp.exp(-m_t))[..., None]
        a = g[..., None] - b_ + i_
        m_new = jnp.maximum(g + m, jnp.max(a, axis=-1))
        decay = jnp.exp(g + m - m_new)
        kw = k_ * jnp.exp(a - m_new[..., None])[..., None]
        C = decay[..., None, None] * C + jnp.einsum("bhsd,bhse->bhde", kw, v_)
        n = decay[..., None] * n + jnp.sum(kw, axis=-2)
        return (C, n, m_new), h

    init = (jnp.zeros((B_, H, d, d), f32), jnp.zeros((B_, H, d), f32), jnp.zeros((B_, H), f32))
    _, hc = lax.scan(step, init, (qc, kc, vc, ic, bc))
    return jnp.moveaxis(hc, 0, 2).reshape(B_, H, S, d)


def _pool_mixer(u, pool_w, pool_scale):
    B_, S, _ = u.shape
    uf = u.astype(jnp.float32)
    cs = jnp.pad(jnp.cumsum(uf, axis=1), ((0, 0), (1, 0), (0, 0)))
    outs = []
    for g, win in enumerate(POOL_WINDOWS):
        sl = slice(g * POOL_GROUP_DIM, (g + 1) * POOL_GROUP_DIM)
        csg = cs[..., sl]
        lower = jnp.pad(csg[:, :S + 1 - win], ((0, 0), (win - 1, 0), (0, 0)))
        cnt = jnp.minimum(jnp.arange(1, S + 1), win).astype(jnp.float32)[None, :, None]
        outs.append((csg[:, 1:] - lower) / cnt - uf[..., sl])
    y = jnp.stack(outs, axis=2).astype(u.dtype)
    y = jnp.einsum("bsgc,gce->bsge", y, pool_w).reshape(B_, S, GROUP_WIDTH)
    return y * pool_scale


def _stick_breaking(q, k, v):
    B_, S, H, d = q.shape
    nb = S // SB_BLOCK
    kh = k.transpose(0, 2, 1, 3)
    vh = v.transpose(0, 2, 1, 3)
    qb = q.reshape(B_, nb, SB_BLOCK, H, d).transpose(1, 0, 3, 2, 4)
    key_pos = jnp.arange(S)

    def one_block(args):
        q_blk, blk = args
        z = jnp.einsum("bhqd,bhsd->bhqs", q_blk, kh).astype(jnp.float32) * (d ** -0.5)
        q_pos = blk * SB_BLOCK + jnp.arange(SB_BLOCK)
        strict = key_pos[None, :] < q_pos[:, None]
        log_keep = jnp.where(strict, jax.nn.log_sigmoid(-z), 0.0)
        log_after = lax.cumsum(log_keep, axis=3, reverse=True) - log_keep
        a = jnp.where(strict, jnp.exp(jax.nn.log_sigmoid(z) + log_after), 0.0)
        return jnp.einsum("bhqs,bhsd->bhqd", a.astype(v.dtype), vh)

    out = lax.map(one_block, (qb, jnp.arange(nb)))
    return out.transpose(1, 0, 3, 2, 4).reshape(B_, S, H, d)


def _conformer_conv(u, dw_w, dw_b, ln_w, ln_b, pw_w, pw_b):
    a, gte = jnp.split(u, 2, axis=-1)
    h = a * jax.nn.sigmoid(gte)
    h = _causal_depthwise_conv(h, dw_w, dw_b)
    h = jax.nn.silu(_layer_norm(h, ln_w, ln_b))
    return h @ pw_w + pw_b


def _heads(t, n_heads):
    B_, S, _ = t.shape
    return t.reshape(B_, S, n_heads, -1).transpose(0, 2, 1, 3)


def _hybrid_mixer(u, w_in, mlstm_conv_w, mlstm_conv_b, mlstm_gate_b, mlstm_norm_w,
                  pool_w, pool_scale, conv_dw_w, conv_dw_b, conv_ln_w, conv_ln_b,
                  conv_pw_w, conv_pw_b, group_norm_w, w_out):
    B_, S, _ = u.shape
    proj = u @ w_in
    bounds = np.cumsum(IN_SPLITS)[:-1].tolist()
    qk_pre, v_m, o_pre, if_pre, pool_in, sb_qkv, conv_in = jnp.split(proj, bounds, axis=-1)

    qk = jax.nn.silu(_causal_depthwise_conv(qk_pre, mlstm_conv_w, mlstm_conv_b))
    q_m, k_m = jnp.split(qk, 2, axis=-1)
    gates = (if_pre + mlstm_gate_b).transpose(0, 2, 1)
    h_m = _mlstm_chunkwise(_heads(q_m, MLSTM_HEADS), _heads(k_m, MLSTM_HEADS), _heads(v_m, MLSTM_HEADS),
                           gates[:, :MLSTM_HEADS], gates[:, MLSTM_HEADS:])
    h_m = h_m.transpose(0, 2, 1, 3)
    mu = jnp.mean(h_m, axis=-1, keepdims=True)
    var = jnp.mean(jnp.square(h_m - mu), axis=-1, keepdims=True)
    h_m = ((h_m - mu) * lax.rsqrt(var + EPS)).reshape(B_, S, GROUP_WIDTH).astype(u.dtype) * mlstm_norm_w
    y_a = jax.nn.sigmoid(o_pre) * h_m

    y_b = _pool_mixer(pool_in, pool_w, pool_scale)

    q_s, k_s, v_s = jnp.split(sb_qkv, 3, axis=-1)
    rs = lambda t: t.reshape(B_, S, SB_HEADS, SB_HEAD_DIM)
    y_c = _stick_breaking(rs(q_s), rs(k_s), rs(v_s)).reshape(B_, S, GROUP_WIDTH)

    y_d = _conformer_conv(conv_in, conv_dw_w, conv_dw_b, conv_ln_w, conv_ln_b, conv_pw_w, conv_pw_b)

    gn_b, gn_c, gn_d = jnp.split(group_norm_w, 3, axis=-1)
    y = jnp.concatenate([y_a, _rms_norm(y_b, gn_b), _rms_norm(y_c, gn_c), _rms_norm(y_d, gn_d)], axis=-1)
    return y @ w_out


def _swiglu(u, w_gate, w_up, w_down):
    return (jax.nn.silu(u @ w_gate) * (u @ w_up)) @ w_down


def _moe(u, router_w, router_b, w_gate, w_up, w_down):
    B_, S, D = u.shape
    t = u.reshape(B_ * S, D)
    logits = (t @ router_w).astype(jnp.float32) + router_b
    top_v, top_i = lax.top_k(logits, TOP_K)
    top_w = jax.nn.softmax(top_v, axis=-1)
    gates = jnp.sum(jax.nn.one_hot(top_i, N_EXPERTS, dtype=jnp.float32) * top_w[..., None], axis=1)
    y = jnp.zeros_like(t)
    for e in range(N_EXPERTS):
        y = y + gates[:, e:e + 1].astype(t.dtype) * _swiglu(t, w_gate[e], w_up[e], w_down[e])
    return y.reshape(B_, S, D)


def setup_inputs(seed: int = 0) -> dict:
    key = jax.random.key(seed)
    ks = list(jax.random.split(key, 32))

    def nrm(shape, std):
        return std * jax.random.normal(ks.pop(), shape, jnp.float32)

    L, D, GW = DEPTH, D_MODEL, GROUP_WIDTH
    gate_offset = jnp.concatenate([jnp.zeros((MLSTM_HEADS,), jnp.float32),
                                   jnp.full((MLSTM_HEADS,), FORGET_BIAS, jnp.float32)])
    return {
        "x": nrm((BATCH, SEQ, D), 1.0),
        "c": nrm((BATCH, D), 1.0),
        "w_in": nrm((L, D, IN_COLS), D ** -0.5),
        "mlstm_conv_w": nrm((L, MLSTM_CONV, 2 * GW), MLSTM_CONV ** -0.5),
        "mlstm_conv_b": nrm((L, 2 * GW), 0.01),
        "mlstm_gate_b": gate_offset + nrm((L, 2 * MLSTM_HEADS), 0.1),
        "mlstm_norm_w": 1.0 + nrm((L, GW), 0.02),
        "pool_w": nrm((L, POOL_GROUPS, POOL_GROUP_DIM, POOL_GROUP_DIM), POOL_GROUP_DIM ** -0.5),
        "pool_scale": 1.0 + nrm((L, GW), 0.1),
        "conv_dw_w": nrm((L, CONV_WIDTH, GW), CONV_WIDTH ** -0.5),
        "conv_dw_b": nrm((L, GW), 0.01),
        "conv_ln_w": 1.0 + nrm((L, GW), 0.02),
        "conv_ln_b": nrm((L, GW), 0.01),
        "conv_pw_w": nrm((L, GW, GW), GW ** -0.5),
        "conv_pw_b": nrm((L, GW), 0.01),
        "group_norm_w": 1.0 + nrm((L, 3 * GW), 0.02),
        "w_out": nrm((L, D, D), BETA * D ** -0.5),
        "ada_w": nrm((L, D, 6 * D), 0.1 * D ** -0.5),
        "ada_b": nrm((L, 6 * D), 0.01),
        "ln1_w": 1.0 + nrm((L, D), 0.02),
        "ln1_b": nrm((L, D), 0.01),
        "ln2_w": 1.0 + nrm((L, D), 0.02),
        "ln2_b": nrm((L, D), 0.01),
        "ffn_w_gate": nrm((N_DENSE, D, D_FF), D ** -0.5),
        "ffn_w_up": nrm((N_DENSE, D, D_FF), D ** -0.5),
        "ffn_w_down": nrm((N_DENSE, D_FF, D), BETA * D_FF ** -0.5),
        "moe_router_w": nrm((N_MOE, D, N_EXPERTS), D ** -0.5),
        "moe_router_b": nrm((N_MOE, N_EXPERTS), 0.01),
        "moe_w_gate": nrm((N_MOE, N_EXPERTS, D, D_FF_EXPERT), D ** -0.5),
        "moe_w_up": nrm((N_MOE, N_EXPERTS, D, D_FF_EXPERT), D ** -0.5),
        "moe_w_down": nrm((N_MOE, N_EXPERTS, D_FF_EXPERT, D), BETA * D_FF_EXPERT ** -0.5),
    }


def reference(x, c, w_in, mlstm_conv_w, mlstm_conv_b, mlstm_gate_b, mlstm_norm_w,
              pool_w, pool_scale, conv_dw_w, conv_dw_b, conv_ln_w, conv_ln_b, conv_pw_w, conv_pw_b,
              group_norm_w, w_out, ada_w, ada_b, ln1_w, ln1_b, ln2_w, ln2_b,
              ffn_w_gate, ffn_w_up, ffn_w_down, moe_router_w, moe_router_b,
              moe_w_gate, moe_w_up, moe_w_down):
    c_act = jax.nn.silu(c)
    for l in range(DEPTH):
        ada = c_act @ ada_w[l] + ada_b[l]
        sh1, sc1, g1, sh2, sc2, g2 = jnp.split(ada[:, None, :], 6, axis=-1)
        u = x * (1.0 + sc1) + sh1
        y = _hybrid_mixer(u, w_in[l], mlstm_conv_w[l], mlstm_conv_b[l], mlstm_gate_b[l], mlstm_norm_w[l],
                          pool_w[l], pool_scale[l], conv_dw_w[l], conv_dw_b[l], conv_ln_w[l], conv_ln_b[l],
                          conv_pw_w[l], conv_pw_b[l], group_norm_w[l], w_out[l])
        x = _layer_norm(ALPHA * x + (1.0 + g1) * y, ln1_w[l], ln1_b[l])
        u = x * (1.0 + sc2) + sh2
        j = l // 2
        if l % 2 == 0:
            y = _swiglu(u, ffn_w_gate[j], ffn_w_up[j], ffn_w_down[j])
        else:
            y = _moe(u, moe_router_w[j], moe_router_b[j], moe_w_gate[j], moe_w_up[j], moe_w_down[j])
        x = _layer_norm(ALPHA * x + (1.0 + g2) * y, ln2_w[l], ln2_b[l])
    return x
```

```cpp
#include <hip/hip_runtime.h>
#include <cstdio>
#include <cstdint>

constexpr int D = 2048, BATCH = 4, SEQ = 2048, M = BATCH * SEQ, GW = 512, INC = 5128, DFF = 5632, NE = 8, DFE = 2816;
constexpr int D6 = 6 * D;
constexpr float ALPHA = 1.41421356237309515f, EPS = 1e-5f;
constexpr int PC = 5120;
constexpr int C_QK = 0, C_V = 1024, C_O = 1536, C_POOL = 2048, C_SB = 2560, C_CONV = 4096;
constexpr int NCHUNK = 32, CH = 64, NBH = 16, NUNIT = NBH * NCHUNK;
constexpr int STATE = 128 * 128 + 128;
constexpr int MAXPANEL = 72, PAIRROWS = MAXPANEL * 256;
typedef unsigned short bf16;

__device__ __forceinline__ float rcpf_(float v) { return __builtin_amdgcn_rcpf(v); }
__device__ __forceinline__ float sigmoidf_(float v) { return rcpf_(1.f + __expf(-v)); }
__device__ __forceinline__ float siluf_(float v) { return v * rcpf_(1.f + __expf(-v)); }
__device__ __forceinline__ float logsigmoidf_(float v) { return fminf(v, 0.f) - log1pf(__expf(-fabsf(v))); }
template <int CTRL> __device__ __forceinline__ float dpp_mov(float v) { return __builtin_bit_cast(float, __builtin_amdgcn_update_dpp(0, __builtin_bit_cast(int, v), CTRL, 0xF, 0xF, true)); }
__device__ __forceinline__ float rdlane(float v, int l) { return __builtin_bit_cast(float, __builtin_amdgcn_readlane(__builtin_bit_cast(int, v), l)); }
__device__ __forceinline__ float wave_sum(float v) {
    v += dpp_mov<0xB1>(v);
    v += dpp_mov<0x4E>(v);
    v += dpp_mov<0x141>(v);
    v += dpp_mov<0x140>(v);
    return (rdlane(v, 0) + rdlane(v, 16)) + (rdlane(v, 32) + rdlane(v, 48));
}
__device__ __forceinline__ float wave_max(float v) {
    v = fmaxf(v, dpp_mov<0xB1>(v)); v = fmaxf(v, dpp_mov<0x4E>(v)); v = fmaxf(v, dpp_mov<0x141>(v)); v = fmaxf(v, dpp_mov<0x140>(v));
    return fmaxf(fmaxf(rdlane(v, 0), rdlane(v, 16)), fmaxf(rdlane(v, 32), rdlane(v, 48)));
}
__device__ __forceinline__ float bf2f(bf16 h) { return __uint_as_float(((unsigned)h) << 16); }
__device__ __forceinline__ unsigned pk2(float lo, float hi) { unsigned r; asm("v_cvt_pk_bf16_f32 %0, %1, %2" : "=v"(r) : "v"(lo), "v"(hi)); return r; }
__device__ __forceinline__ unsigned f2bf(float f) { return pk2(f, 0.f) & 0xffffu; }
__device__ __forceinline__ float bflo(unsigned u) { return __uint_as_float(u << 16); }
__device__ __forceinline__ float bfhi(unsigned u) { return __uint_as_float(u & 0xffff0000u); }
namespace pg8 {
#define PG8_LAS __attribute__((address_space(3)))
typedef unsigned short bf16_t;
typedef short bf16x8 __attribute__((ext_vector_type(8)));
typedef float f32x4 __attribute__((ext_vector_type(4)));
typedef unsigned u32x4 __attribute__((ext_vector_type(4)));
constexpr int BM = 256, BK = 64, HALF = 128, HTB = HALF * BK * 2  , STAGE_BYTES = 8 * HTB, NXCD = 8, WGM = 8;

__host__ __device__ __forceinline__ int lds_byte(int r, int c) { const int st = (r >> 4) * 2 + (c >> 5), rr = r & 15, cc = c & 31, ob = rr * 64 + cc * 2; return st * 1024 + (ob ^ (((ob >> 9) & 1) << 5)); }
__host__ __device__ __forceinline__ void stage_rc(int b, int& R, int& C) { const int st = b / 1024, sb = b % 1024, swz = sb ^ (((sb >> 9) & 1) << 5); R = (st >> 1) * 16 + swz / 64; C = (st & 1) * 32 + (swz % 64) / 2; }
__host__ __device__ __forceinline__ int perm32(int rho) { const int n = rho >> 4, i = rho & 15; return 8 * (i >> 2) + 4 * n + (i & 3); }

struct Unit { int pm, pn; };
struct Gemm { const bf16_t* A; const bf16_t* Bt; int M, N, K; };

struct StaticOrder {
    static constexpr bool GATHER = false;
    int nM, nN, nwg, G, c;
    __host__ __device__ void init(int M, int N, int G_, int c_) { nM = M / BM; nN = N / BM; nwg = nM * nN; G = G_; c = c_; }
    __host__ __device__ bool next(int i, Unit& u) const {
        const long L = (long)i * G + c; if (L >= nwg) return false;
        int wgid = (int)L; { const int q = nwg / NXCD, r = nwg % NXCD, xcd = wgid % NXCD, off = wgid / NXCD; wgid = (xcd < r ? xcd * (q + 1) : r * (q + 1) + (xcd - r) * q) + off; }
        const int nig = WGM * nN, gid = wgid / nig, fm = gid * WGM, gsz = (nM - fm) < WGM ? (nM - fm) : WGM;
        u.pm = fm + ((wgid % nig) % gsz); u.pn = (wgid % nig) / gsz; return true;
    }
    __device__ __forceinline__ void a_ready(const Unit&) const {}
    __device__ __forceinline__ void done(const Unit&) const {}
};
__device__ __forceinline__ unsigned cvt_pk_bf16(float lo, float hi) { unsigned r; asm volatile("v_cvt_pk_bf16_f32 %0, %1, %2" : "=v"(r) : "v"(lo), "v"(hi)); return r; }
typedef float f32x2 __attribute__((ext_vector_type(2)));
__device__ __forceinline__ f32x2 gelu_pk(f32x2 v) {
    const f32x2 av = __builtin_elementwise_abs(v), d = av * 0.2316418882f + 1.0f;
    f32x2 t; t.x = __builtin_amdgcn_rcpf(d.x); t.y = __builtin_amdgcn_rcpf(d.y);
    f32x2 q = t * 0.5307027145f + (-0.7265760135f); q = q * t + 0.7107068705f; q = q * t + (-0.142248368f); q = q * t + 0.127414796f; q = q * t;
    const f32x2 s = (v * v) * (-0.72134752044f);
    f32x2 e; e.x = __builtin_amdgcn_exp2f(s.x); e.y = __builtin_amdgcn_exp2f(s.y);
    const f32x2 m = v * (q * e), r = v - m;
    f32x2 o; o.x = v.x < 0.f ? m.x : r.x; o.y = v.y < 0.f ? m.y : r.y; return o;
}

template <int ACT  > struct EpiBf16 {
    static constexpr bool PERM = true, AFTER_DRAIN = false; static_assert(ACT == 0 || ACT == 1, "EpiBf16: ACT is 0 (none) or 1 (gelu_pk)");
    bf16_t* O; int ldc; const float* bias; int split_cols; size_t split_stride; float scale0;
    __device__ __forceinline__ void operator()(const f32x4 (&acc)[2][2][4][2], const Unit& u, int wr, int wc, int fr, int fq) const {
        const int row0 = u.pm * BM + wr * 64 + fr; int colt = u.pn * BM; bf16_t* base = O;
        float sc = 1.f; if (split_cols) { const int t = colt / split_cols; base += (size_t)t * split_stride; colt -= t * split_cols; if (t == 0) sc = scale0; }
        const int col0 = colt + wc * 32 + 8 * fq, bcol0 = u.pn * BM + wc * 32 + 8 * fq;
        f32x4 bv[2][2];
#pragma unroll
        for (int bj = 0; bj < 2; ++bj)
#pragma unroll
            for (int n = 0; n < 2; ++n) bv[bj][n] = bias ? *(const f32x4*)(bias + bcol0 + bj * HALF + 4 * n) : (f32x4){0.f, 0.f, 0.f, 0.f};
#pragma unroll
        for (int ai = 0; ai < 2; ++ai)
#pragma unroll
            for (int m = 0; m < 4; ++m) { bf16_t* rowp = base + (size_t)(row0 + ai * HALF + m * 16) * ldc + col0;
#pragma unroll
                for (int bj = 0; bj < 2; ++bj) { f32x4 v0 = acc[ai][bj][m][0] + bv[bj][0], v1 = acc[ai][bj][m][1] + bv[bj][1];
                    if (ACT == 1) { f32x2 a = gelu_pk((f32x2){v0[0], v0[1]}), b = gelu_pk((f32x2){v0[2], v0[3]}), c = gelu_pk((f32x2){v1[0], v1[1]}), d = gelu_pk((f32x2){v1[2], v1[3]});
                        v0 = (f32x4){a.x, a.y, b.x, b.y}; v1 = (f32x4){c.x, c.y, d.x, d.y}; }
                    v0 = v0 * sc; v1 = v1 * sc; u32x4 w; w.x = cvt_pk_bf16(v0[0], v0[1]); w.y = cvt_pk_bf16(v0[2], v0[3]); w.z = cvt_pk_bf16(v1[0], v1[1]); w.w = cvt_pk_bf16(v1[2], v1[3]);
                    *(u32x4*)(rowp + bj * HALF) = w; } }
    }
};
template <class Epi, class Sched, bool ALIGN_EPI = false, bool SP2 = false>
__device__ __forceinline__ void gemm_phase(PG8_LAS unsigned char* lds, const Gemm g, const Sched& S, const Epi& E) {
    int tid_ = threadIdx.x; asm volatile("" : "+v"(tid_));
    const int tid = tid_, wid = __builtin_amdgcn_readfirstlane(tid >> 6), lane = tid & 63, wr = wid >> 2, wc = wid & 3, fr = lane & 15, fq = lane >> 4;
    const int K = g.K, nt = K / BK;
    unsigned voffA[2], voffB[2];
    { int R, C; stage_rc(tid * 16, R, C); const int Rb = Epi::PERM ? ((R & ~31) + perm32(R & 31)) : R;
        voffA[0] = (unsigned)(R * K + C) * 2u; voffB[0] = (unsigned)(Rb * K + C) * 2u;
        voffA[1] = voffA[0] + (unsigned)(64 * K * 2); voffB[1] = voffB[0] + (unsigned)(64 * K * 2); }
    unsigned pkA0 = 0u, pkA1 = 0u;
#define PG8_GOFF(uidx) do { if constexpr (Sched::GATHER) { int _R0, _C0, _R1, _C1; stage_rc(tid * 16, _R0, _C0); stage_rc(tid * 16 + 8192, _R1, _C1); \
        pkA0 = (unsigned)S.idx[(uidx) * 256 + _R0] | ((unsigned)S.idx[(uidx) * 256 + _R1] << 16); pkA1 = (unsigned)S.idx[(uidx) * 256 + HALF + _R0] | ((unsigned)S.idx[(uidx) * 256 + HALF + _R1] << 16); } } while (0)
#define PG8_STAGE_A(bufoff, gbase, h) do { unsigned _o[2]; if constexpr (Sched::GATHER) { int _R, _C; stage_rc(tid * 16, _R, _C); const unsigned _p = (h) ? pkA1 : pkA0; \
        _o[0] = ((_p & 0xffffu) * (unsigned)K + (unsigned)_C) * 2u; _o[1] = ((_p >> 16) * (unsigned)K + (unsigned)_C) * 2u; } else { _o[0] = voffA[0]; _o[1] = voffA[1]; } \
        PG8_STAGE(bufoff, gbase, _o); } while (0)
    const size_t kstep = (size_t)(BK * 2);
    const size_t hstep = (size_t)HALF * K * 2;
    const size_t tstep = 2 * hstep;
    const size_t hstepA = Sched::GATHER ? 0 : hstep, tstepA = Sched::GATHER ? 0 : tstep;
    const unsigned ldsw = (unsigned)wid * 1024u;
    const int aoff = lds_byte(wr * 64 + fr, fq * 8), boff = lds_byte(wc * 32 + fr, fq * 8);
#define PG8_SA(b, h) (((b) * 2 + (h)) * HTB)
#define PG8_SB(b, h) ((4 + (b) * 2 + (h)) * HTB)
#define PG8_STAGE(bufoff, gbase, voff) do { _Pragma("unroll") for (int _i = 0; _i < 2; ++_i) \
        __builtin_amdgcn_global_load_lds((const unsigned*)((const char*)(gbase) + (voff)[_i]), (PG8_LAS unsigned*)(lds + (bufoff) + ldsw + _i * 8192), 16, 0, 0); } while (0)
#define PG8_LDA(dst, b, h) do { _Pragma("unroll") for (int m = 0; m < 4; ++m) _Pragma("unroll") for (int k = 0; k < 2; ++k) dst[m][k] = *(const PG8_LAS bf16x8*)(lds + PG8_SA(b, h) + aoff + m * 2048 + k * 1024); } while (0)
#define PG8_LDB(dst, b, h) do { _Pragma("unroll") for (int n = 0; n < 2; ++n) _Pragma("unroll") for (int k = 0; k < 2; ++k) dst[n][k] = *(const PG8_LAS bf16x8*)(lds + PG8_SB(b, h) + boff + n * 2048 + k * 1024); } while (0)
#define PG8_MMA(ai, bj, At, Bt) do { __builtin_amdgcn_s_setprio(1); _Pragma("unroll") for (int m = 0; m < 4; ++m) _Pragma("unroll") for (int n = 0; n < 2; ++n) _Pragma("unroll") for (int k = 0; k < 2; ++k) \
        acc[ai][bj][m][n] = __builtin_amdgcn_mfma_f32_16x16x32_bf16(Bt[n][k], At[m][k], acc[ai][bj][m][n], 0, 0, 0); __builtin_amdgcn_s_setprio(0); } while (0)
#define PG8_WAIT_V(n) asm volatile("s_waitcnt vmcnt(" #n ")" ::: "memory")
#define PG8_WAIT_L(n) asm volatile("s_waitcnt lgkmcnt(" #n ")" ::: "memory")
#define PG8_BAR __builtin_amdgcn_s_barrier()
#define PG8_SCHED __builtin_amdgcn_sched_barrier(0)
    Unit cur, nxt; int ui = 0;
    if (!S.next(0, cur)) return;
    f32x4 acc[2][2][4][2];
#pragma unroll
    for (int a = 0; a < 2; ++a)
#pragma unroll
        for (int b = 0; b < 2; ++b)
#pragma unroll
            for (int m = 0; m < 4; ++m)
#pragma unroll
                for (int n = 0; n < 2; ++n) acc[a][b][m][n] = (f32x4){0.f, 0.f, 0.f, 0.f};
    bf16x8 At[4][2], B0[2][2], B1[2][2];
    const char* cA = (const char*)g.A + (size_t)cur.pm * tstepA; const char* cB = (const char*)g.Bt + (size_t)cur.pn * tstep;
    PG8_GOFF(0);
    S.a_ready(cur);
    if constexpr (SP2) {
        PG8_STAGE(PG8_SB(0, 0), cB, voffB); PG8_STAGE(PG8_SB(0, 1), cB + hstep, voffB); PG8_STAGE_A(PG8_SA(0, 0), cA, 0); PG8_STAGE_A(PG8_SA(0, 1), cA + hstepA, 1);
        if (wr == 1) PG8_BAR;
        PG8_WAIT_V(2); PG8_BAR;
        PG8_STAGE(PG8_SB(1, 0), cB + kstep, voffB); PG8_STAGE_A(PG8_SA(1, 0), cA + kstep, 0); PG8_STAGE(PG8_SB(1, 1), cB + hstep + kstep, voffB);
        PG8_WAIT_V(6); PG8_BAR;
    } else {
        PG8_STAGE(PG8_SB(0, 0), cB, voffB); PG8_STAGE_A(PG8_SA(0, 0), cA, 0); PG8_STAGE(PG8_SB(0, 1), cB + hstep, voffB); PG8_STAGE_A(PG8_SA(0, 1), cA + hstepA, 1);
        if (wr == 1) PG8_BAR;
        PG8_WAIT_V(4); PG8_BAR;
        PG8_STAGE(PG8_SB(1, 0), cB + kstep, voffB); PG8_STAGE_A(PG8_SA(1, 0), cA + kstep, 0); PG8_STAGE(PG8_SB(1, 1), cB + hstep + kstep, voffB);
        PG8_WAIT_V(6); PG8_BAR;
    }
    for (;;) {
        const bool has_next = S.next(ui + 1, nxt);
        const char* nA = has_next ? (const char*)g.A + (size_t)nxt.pm * tstepA : cA; const char* nB = has_next ? (const char*)g.Bt + (size_t)nxt.pn * tstep : cB;
        for (int t = 0; t < nt; t += 2) {
            const bool last = (t == nt - 2);

            const char* a1 = cA + (size_t)(t + 1) * kstep;
            const char* a2 = last ? nA : cA + (size_t)(t + 2) * kstep; const char* b2 = last ? nB : cB + (size_t)(t + 2) * kstep;
            const char* a3 = a2 + kstep; const char* b3 = b2 + kstep;
            if (last && has_next) S.a_ready(nxt);
            if constexpr (SP2) {
            PG8_LDB(B0, 0, 0); PG8_LDB(B1, 0, 1); PG8_SCHED; PG8_LDA(At, 0, 0); PG8_STAGE_A(PG8_SA(1, 1), a1 + hstepA, 1); if (last) PG8_GOFF(has_next ? ui + 1 : ui);
            PG8_WAIT_V(8); PG8_WAIT_L(0); PG8_BAR; PG8_MMA(0, 0, At, B0); PG8_MMA(0, 1, At, B1); PG8_BAR; PG8_SCHED;
            PG8_LDA(At, 0, 1); PG8_STAGE(PG8_SB(0, 0), b2, voffB); PG8_STAGE(PG8_SB(0, 1), b2 + hstep, voffB); PG8_STAGE_A(PG8_SA(0, 0), a2, 0);
            PG8_WAIT_V(8); PG8_WAIT_L(0); PG8_BAR; PG8_MMA(1, 0, At, B0); PG8_MMA(1, 1, At, B1); PG8_BAR; PG8_SCHED;
            PG8_LDB(B0, 1, 0); PG8_LDB(B1, 1, 1); PG8_SCHED; PG8_LDA(At, 1, 0); PG8_STAGE_A(PG8_SA(0, 1), a2 + hstepA, 1);
            PG8_WAIT_V(8); PG8_WAIT_L(0); PG8_BAR; PG8_MMA(0, 0, At, B0); PG8_MMA(0, 1, At, B1); PG8_BAR; PG8_SCHED;
            PG8_LDA(At, 1, 1); PG8_STAGE(PG8_SB(1, 0), b3, voffB); PG8_STAGE(PG8_SB(1, 1), b3 + hstep, voffB); PG8_STAGE_A(PG8_SA(1, 0), a3, 0);
            PG8_WAIT_V(8); PG8_WAIT_L(0); PG8_BAR; PG8_MMA(1, 0, At, B0); PG8_MMA(1, 1, At, B1); PG8_BAR; PG8_SCHED;
            } else {
            PG8_LDB(B0, 0, 0); PG8_SCHED; PG8_LDA(At, 0, 0); PG8_STAGE_A(PG8_SA(1, 1), a1 + hstepA, 1); if (last) PG8_GOFF(has_next ? ui + 1 : ui);
            PG8_WAIT_L(8); PG8_BAR; PG8_WAIT_L(0); PG8_MMA(0, 0, At, B0); PG8_BAR; PG8_SCHED;
            PG8_LDB(B1, 0, 1); PG8_STAGE(PG8_SB(0, 0), b2, voffB);
            PG8_BAR; PG8_WAIT_L(0); PG8_MMA(0, 1, At, B1); PG8_BAR;
            PG8_LDA(At, 0, 1); PG8_STAGE_A(PG8_SA(0, 0), a2, 0);
            PG8_BAR; PG8_WAIT_L(0); PG8_MMA(1, 0, At, B0); PG8_BAR; PG8_SCHED;
            PG8_STAGE(PG8_SB(0, 1), b2 + hstep, voffB);
            PG8_WAIT_V(6); PG8_BAR; PG8_MMA(1, 1, At, B1); PG8_BAR;
            PG8_LDB(B0, 1, 0); PG8_SCHED; PG8_LDA(At, 1, 0); PG8_STAGE_A(PG8_SA(0, 1), a2 + hstepA, 1);
            PG8_WAIT_L(8); PG8_BAR; PG8_WAIT_L(0); PG8_MMA(0, 0, At, B0); PG8_BAR; PG8_SCHED;
            PG8_LDB(B1, 1, 1); PG8_STAGE(PG8_SB(1, 0), b3, voffB);
            PG8_BAR; PG8_WAIT_L(0); PG8_MMA(0, 1, At, B1); PG8_BAR;
            PG8_LDA(At, 1, 1); PG8_STAGE_A(PG8_SA(1, 0), a3, 0);
            PG8_BAR; PG8_WAIT_L(0); PG8_MMA(1, 0, At, B0); PG8_BAR; PG8_SCHED;
            PG8_STAGE(PG8_SB(1, 1), b3 + hstep, voffB);
            PG8_WAIT_V(6); PG8_BAR; PG8_MMA(1, 1, At, B1); PG8_BAR;
            }
        }
        if constexpr (ALIGN_EPI) { if (wr == 0) PG8_BAR; }
        if constexpr (!Epi::AFTER_DRAIN) { E(acc, cur, wr, wc, fr, fq); S.done(cur); }
        if (!has_next) break;
#pragma unroll
        for (int a = 0; a < 2; ++a)
#pragma unroll
            for (int b = 0; b < 2; ++b)
#pragma unroll
                for (int m = 0; m < 4; ++m)
#pragma unroll
                    for (int n = 0; n < 2; ++n) acc[a][b][m][n] = (f32x4){0.f, 0.f, 0.f, 0.f};
        cur = nxt; cA = nA; cB = nB; ++ui;
        if constexpr (ALIGN_EPI) { if (wr == 1) PG8_BAR; }
    }
    PG8_WAIT_V(0);
    if constexpr (!ALIGN_EPI) { if (wr == 0) PG8_BAR; }
    PG8_BAR;
    if constexpr (Epi::AFTER_DRAIN) { E.fused(acc, cur, wr, wc, fr, fq, lds, wid, lane); S.done(cur); }
#undef PG8_SA
#undef PG8_SB
#undef PG8_STAGE
#undef PG8_LDA
#undef PG8_LDB
#undef PG8_MMA
#undef PG8_WAIT_V
#undef PG8_WAIT_L
#undef PG8_BAR
#undef PG8_SCHED
#undef PG8_GOFF
#undef PG8_STAGE_A
}
}
namespace pg8 {
struct EpiResid {
    static constexpr bool PERM = false, AFTER_DRAIN = false;
    bf16_t* T; const float* Xin; const float* stats; const float* lw; const float* lb; const float* g;
    __device__ __forceinline__ void operator()(const f32x4 (&acc)[2][2][4][2], const Unit& u, int wr, int wc, int fr, int fq) const {
        typedef unsigned u32x2 __attribute__((ext_vector_type(2))); typedef float f32x2v __attribute__((ext_vector_type(2)));
        const int row0 = u.pm * BM + wr * 64 + fr, col0 = u.pn * BM + wc * 32 + 4 * fq; const int b = (u.pm * BM) / SEQ;
        const bool fromx = (Xin != nullptr);
#pragma unroll
        for (int bj = 0; bj < 2; ++bj)
#pragma unroll
            for (int n = 0; n < 2; ++n) { const int c = col0 + bj * HALF + n * 16;
                const f32x4 gv = *(const f32x4*)(g + (size_t)b * D6 + c) + 1.0f;
                f32x4 wv = (f32x4){0.f, 0.f, 0.f, 0.f}, bv = wv; if (!fromx) { wv = *(const f32x4*)(lw + c); bv = *(const f32x4*)(lb + c); }
#pragma unroll
                for (int ai = 0; ai < 2; ++ai)
#pragma unroll
                    for (int m = 0; m < 4; ++m) { const int r = row0 + ai * HALF + m * 16; const size_t off = (size_t)r * D + c; f32x4 xv;
                        if (fromx) xv = *(const f32x4*)(Xin + off);
                        else { const u32x2 tw = *(const u32x2*)(T + off); const f32x2v st = *(const f32x2v*)(stats + 2 * (size_t)r);
                            xv = (f32x4){__uint_as_float(tw.x << 16), __uint_as_float(tw.x & 0xffff0000u), __uint_as_float(tw.y << 16), __uint_as_float(tw.y & 0xffff0000u)};
                            xv = (xv - st.x) * st.y * wv + bv; }
                        const f32x4 tv = xv * ALPHA + gv * acc[ai][bj][m][n];
                        u32x2 w; w.x = cvt_pk_bf16(tv[0], tv[1]); w.y = cvt_pk_bf16(tv[2], tv[3]); *(u32x2*)(T + off) = w;
                        if (m & 1) asm volatile("" ::: "memory"); } }
    }
};
struct EpiBf16P {
    static constexpr bool PERM = true, AFTER_DRAIN = false;
    bf16_t* O; int ldc; int nN;
    __device__ __forceinline__ void operator()(const f32x4 (&acc)[2][2][4][2], const Unit& u, int wr, int wc, int fr, int fq) const {
        const int row0 = u.pm * BM + wr * 64 + fr, col0 = (u.pn % nN) * BM + wc * 32 + 8 * fq;
#pragma unroll
        for (int ai = 0; ai < 2; ++ai)
#pragma unroll
            for (int m = 0; m < 4; ++m) { bf16_t* rowp = O + (size_t)(row0 + ai * HALF + m * 16) * ldc + col0;
#pragma unroll
                for (int bj = 0; bj < 2; ++bj) { const f32x4 v0 = acc[ai][bj][m][0], v1 = acc[ai][bj][m][1];
                    u32x4 w; w.x = cvt_pk_bf16(v0[0], v0[1]); w.y = cvt_pk_bf16(v0[2], v0[3]); w.z = cvt_pk_bf16(v1[0], v1[1]); w.w = cvt_pk_bf16(v1[2], v1[3]);
                    *(u32x4*)(rowp + bj * HALF) = w; } }
    }
};
__device__ __forceinline__ float silu_fast(float v) { return v * __builtin_amdgcn_rcpf(1.0f + __builtin_amdgcn_exp2f(-1.44269504089f * v)); }
struct EpiSwiglu {
    static constexpr bool PERM = true, AFTER_DRAIN = false;
    bf16_t* H; int ldc; int nN;
    __device__ __forceinline__ void operator()(const f32x4 (&acc)[2][2][4][2], const Unit& u, int wr, int wc, int fr, int fq) const {
        const int row0 = u.pm * BM + wr * 64 + fr, col0 = (u.pn % nN) * HALF + wc * 32 + 8 * fq;
#pragma unroll
        for (int ai = 0; ai < 2; ++ai)
#pragma unroll
            for (int m = 0; m < 4; ++m) { bf16_t* rowp = H + (size_t)(row0 + ai * HALF + m * 16) * ldc + col0;
                const f32x4 g0 = acc[ai][0][m][0], g1 = acc[ai][0][m][1], u0 = acc[ai][1][m][0], u1 = acc[ai][1][m][1];
                float h[8];
#pragma unroll
                for (int j = 0; j < 4; ++j) { h[j] = silu_fast(g0[j]) * u0[j]; h[4 + j] = silu_fast(g1[j]) * u1[j]; }
                u32x4 w; w.x = cvt_pk_bf16(h[0], h[1]); w.y = cvt_pk_bf16(h[2], h[3]); w.z = cvt_pk_bf16(h[4], h[5]); w.w = cvt_pk_bf16(h[6], h[7]);
                *(u32x4*)rowp = w; }
    }
};
struct MoeOrder : StaticOrder {
    const int* panel_e; int nNl;
    __device__ __forceinline__ bool next(int i, Unit& u) const { if (!StaticOrder::next(i, u)) return false; u.pn += panel_e[u.pm] * nNl; return true; }
};
struct MoeGatherOrder : MoeOrder { static constexpr bool GATHER = true; const PG8_LAS int* idx; };
}
#ifndef PG8_SP2
#define PG8_SP2 true
#endif
#ifndef PG8_ALIGN
#define PG8_ALIGN true
#endif
constexpr size_t al256(size_t x) { return (x + 255) & ~(size_t)255; }
constexpr size_t WS_CTL = 0, CTL_ZERO_BYTES = 1u << 20;
constexpr size_t WS_ADA = CTL_ZERO_BYTES;
constexpr size_t WS_PART = WS_ADA + al256((size_t)2 * 4 * D6 * 4);
constexpr size_t WS_GATES = WS_PART + al256((size_t)2 * 16 * 4 * D6 * 4);
constexpr size_t WS_TOKE = WS_GATES + al256((size_t)M * 8 * 4);
constexpr size_t WS_TOKW = WS_TOKE + al256((size_t)M * 2 * 4);
constexpr size_t WS_CNT = WS_TOKW + al256((size_t)M * 2 * 4);
constexpr size_t WS_PPOS = WS_CNT + al256(256 * 8 * 4);
constexpr size_t WS_PANE = WS_PPOS + al256((size_t)M * 2 * 4);
constexpr size_t WS_RTOK = WS_PANE + al256(512);
constexpr size_t WS_WIN = WS_RTOK + al256((size_t)PAIRROWS * 4);
constexpr size_t WS_WOUT = WS_WIN + (size_t)2 * PC * D * 2;
constexpr size_t WS_WGU = WS_WOUT + (size_t)2 * D * D * 2;
constexpr size_t WS_WD = WS_WGU + (size_t)2 * DFF * D * 2;
constexpr size_t WS_MWGU = WS_WD + (size_t)D * DFF * 2;
constexpr size_t WS_MWD = WS_MWGU + (size_t)NE * 2 * DFE * D * 2;
constexpr size_t WS_PWT = WS_MWD + (size_t)NE * D * DFE * 2;
constexpr size_t WS_PLT = WS_PWT + (size_t)2 * GW * GW * 2;
constexpr size_t WS_U = WS_PLT + (size_t)2 * 4 * 128 * 128 * 2;
constexpr size_t WS_X = WS_U + (size_t)M * D * 2;
constexpr size_t WS_T = WS_X + (size_t)M * D * 4;
constexpr size_t WS_YCAT = WS_T + (size_t)M * D * 4;
constexpr size_t WS_PROJ = WS_YCAT + (size_t)M * D * 2;
constexpr size_t WS_H = WS_PROJ + (size_t)M * PC * 2;
constexpr size_t WS_NAIVE = WS_H + (size_t)PAIRROWS * DFE * 2;
static_assert((size_t)PAIRROWS * D * 2 <= (size_t)M * PC * 2 && (size_t)M * DFF <= (size_t)PAIRROWS * DFE, "overlays");
constexpr int CW_TMO = 0, CW_CODE = 1, CW_BAR = 4096;
constexpr int RING_OFF = 0, RING_BYTES = 131072, LDSCTL_OFF = RING_BYTES, MISC_OFF = LDSCTL_OFF + 320, LDS_BYTES = 147456;
constexpr int NWAVES = 8, NTHR = 512;

#define GAS __attribute__((address_space(1)))
#define LAS __attribute__((address_space(3)))
typedef unsigned v4u __attribute__((ext_vector_type(4)));
typedef unsigned v2u __attribute__((ext_vector_type(2)));
typedef float f32x4 __attribute__((ext_vector_type(4)));
#define LDS_WAIT() asm volatile("s_waitcnt lgkmcnt(0)" ::: "memory")
#define XB_TMO      128
#define XB_XCNT(j)  (256  + 64 * (j))
#define XB_XSUB(j)  (1280 + 64 * (j))
#define XB_XGEN(j)  (2304 + 64 * (j))
#define XB_TOP      3328
#define XB_TOPGEN   3392
#define XCD_BAR_WORDS 3456
#define XB_SPIN_CAP (1u << 18)

__device__ __forceinline__ unsigned xb_ld(unsigned* p)              { return __hip_atomic_load(p, __ATOMIC_RELAXED, __HIP_MEMORY_SCOPE_AGENT); }
__device__ __forceinline__ unsigned xb_add(unsigned* p, unsigned v) { return __hip_atomic_fetch_add(p, v, __ATOMIC_RELAXED, __HIP_MEMORY_SCOPE_AGENT); }
__device__ __forceinline__ unsigned xb_xcc_id() { return (unsigned)__builtin_amdgcn_s_getreg((3 << 11) | 20) & 0xFu; }
#define XB_SPIN(cond, bar) do { unsigned _sp = 0; while (cond) { __builtin_amdgcn_s_sleep(1); \
    if ((++_sp & 255u) == 0u) { if (xb_ld(&(bar)[XB_TMO])) break; if (_sp > XB_SPIN_CAP) { atomicAdd(&(bar)[XB_TMO], 1u); break; } } } } while (0)

struct XcdBarrier {
    unsigned* bar; unsigned x;
    volatile LAS unsigned* st;
};

__device__ __forceinline__ XcdBarrier xcd_barrier_post(unsigned* bar, volatile LAS unsigned* st) {
    XcdBarrier b; b.bar = bar; b.x = xb_xcc_id(); b.st = st;
    if (threadIdx.x == 0) (void)xb_add(&bar[XB_XCNT(b.x)], 1u);
    return b;
}
__device__ __forceinline__ void xcd_barrier_complete(unsigned* bar, unsigned x, unsigned& nloc, unsigned& nx) {
    const unsigned G = gridDim.x * gridDim.y * gridDim.z;
    unsigned sum, cnt, mine, sp = 0u;
    for (;;) {
        sum = 0u; cnt = 0u; mine = 0u;
#pragma unroll
        for (unsigned j = 0; j < 16; ++j) { const unsigned c = xb_ld(&bar[XB_XCNT(j)]); sum += c; cnt += (c > 0u) ? 1u : 0u; mine = (j == x) ? c : mine; }
        if (sum == G) break;
        __builtin_amdgcn_s_sleep(1);
        if ((++sp & 255u) == 0u) { if (xb_ld(&bar[XB_TMO])) break; if (sp > XB_SPIN_CAP) { atomicAdd(&bar[XB_TMO], 1u); break; } }
    }
    nloc = mine > 0u ? mine : 1u; nx = cnt > 0u ? cnt : 1u;
}

__device__ __forceinline__ void xcd_barrier(const XcdBarrier& b) {
    asm volatile("s_waitcnt vmcnt(0)" ::: "memory");
    __syncthreads();
    if (threadIdx.x == 0) {
        unsigned* bar = b.bar;
        __builtin_amdgcn_s_waitcnt(0);
        unsigned nloc = b.st[0], nx = b.st[1];
        if (nloc == 0u) { xcd_barrier_complete(bar, b.x, nloc, nx); b.st[0] = nloc; b.st[1] = nx; }
        const unsigned old = xb_add(&bar[XB_XSUB(b.x)], 1u);
        const unsigned gen = old / nloc;
        if (old + 1u == (gen + 1u) * nloc) {
            __builtin_amdgcn_fence(__ATOMIC_RELEASE, "agent");
            asm volatile("s_waitcnt vmcnt(0)" ::: "memory");
            const unsigned og = xb_add(&bar[XB_TOP], 1u);
            const unsigned tg = og / nx;
            if (og + 1u == (tg + 1u) * nx) xb_add(&bar[XB_TOPGEN], 1u);
            else XB_SPIN(xb_ld(&bar[XB_TOPGEN]) == tg, bar);
            __builtin_amdgcn_fence(__ATOMIC_ACQUIRE, "agent");
            xb_add(&bar[XB_XGEN(b.x)], 1u);
            asm volatile("s_waitcnt vmcnt(0)" ::: "memory");
        } else {
            XB_SPIN(xb_ld(&bar[XB_XGEN(b.x)]) == gen, bar);
            __builtin_amdgcn_fence(__ATOMIC_ACQUIRE, "agent");
            asm volatile("s_waitcnt vmcnt(0)" ::: "memory");
        }
    }
    __syncthreads();
}
struct Args { const float* in[31]; float* out; unsigned char* ws; int ph_lo, ph_hi, li, pad; };
struct Frame { LAS unsigned char* lds; int G, bid; unsigned char* ws; };
__device__ __forceinline__ int otid() { int t = threadIdx.x; asm volatile("" : "+v"(t)); return t; }
#define PHASE_IDS const int tid = otid(), lane = tid & 63, wave = __builtin_amdgcn_readfirstlane(tid >> 6); (void)lane; (void)wave

struct CItem { const float* src; bf16* dst; int ld, K; };
__device__ __forceinline__ void conv_load(const CItem& c, float (&tv)[64], int lane) {
#pragma unroll
    for (int i = 0; i < 64; ++i) tv[i] = __builtin_nontemporal_load(c.src + (size_t)i * c.ld + lane);
}
template <bool NT = false> __device__ __forceinline__ void conv_store(const CItem& c, const float (&tv)[64], LAS bf16* scr, int lane) {
#pragma unroll
    for (int i = 0; i < 64; i += 2) *(LAS unsigned*)(scr + lane * 66 + i) = pk2(tv[i], tv[i + 1]);
    LDS_WAIT(); asm volatile("" ::: "memory");
#pragma unroll
    for (int q = 0; q < 8; ++q) { const int pce = lane + 64 * q, n = pce >> 3, cc = pce & 7; const LAS unsigned* s = (const LAS unsigned*)(scr + n * 66 + cc * 8);
        v4u o; o.x = s[0]; o.y = s[1]; o.z = s[2]; o.w = s[3];
        if (NT) __builtin_nontemporal_store(o, (v4u*)(c.dst + (size_t)n * c.K + 8 * cc)); else *(v4u*)(c.dst + (size_t)n * c.K + 8 * cc) = o; }
    LDS_WAIT(); asm volatile("" ::: "memory");
}
constexpr int I_IN = (PC / 64) * (D / 64), I_OUT = (D / 64) * (D / 64), I_GU = (2 * DFF / 64) * (D / 64), I_D = (D / 64) * (DFF / 64);
constexpr int I_MGU = (2 * DFE / 64) * (D / 64), I_MD = (D / 64) * (DFE / 64), I_PW = (GW / 64) * (GW / 64), I_PL = (128 / 64) * (128 / 64);
constexpr int NITEMS = 2 * I_IN + 2 * I_OUT + I_GU + I_D + NE * I_MGU + NE * I_MD + 2 * I_PW + 8 * I_PL;
__device__ __forceinline__ CItem conv_decode(const Frame& F, const Args& a, int it) {
    CItem c;
        int r = it;
        if (r < 2 * I_IN) { const int l = r / I_IN; r %= I_IN; const int rb = r % (PC / 64), kb = r / (PC / 64); const int n0 = rb * 64 + (rb * 64 >= 2048 ? 8 : 0);
            c.src = (a.in[2] + (size_t)l * D * INC) + (size_t)(kb * 64) * (INC) + (n0); c.ld = INC; c.dst = ((bf16*)(F.ws + WS_WIN) + ((size_t)l * PC + rb * 64) * D) + (kb * 64); c.K = D; return c; } r -= 2 * I_IN;
        if (r < 2 * I_OUT) { const int l = r / I_OUT; r %= I_OUT; const int rb = r % (D / 64), kb = r / (D / 64);
            c.src = (a.in[16] + (size_t)l * D * D) + (size_t)(kb * 64) * (D) + (rb * 64); c.ld = D; c.dst = ((bf16*)(F.ws + WS_WOUT) + ((size_t)l * D + rb * 64) * D) + (kb * 64); c.K = D; return c; } r -= 2 * I_OUT;
        if (r < I_GU) { const int rb = r % (2 * DFF / 64), kb = r / (2 * DFF / 64), row = rb * 64, j = row / 256, w = row % 256;
            c.src = (w < 128 ? a.in[23] : a.in[24]) + (size_t)(kb * 64) * (DFF) + (128 * j + (w & 127)); c.ld = DFF; c.dst = ((bf16*)(F.ws + WS_WGU) + (size_t)row * D) + (kb * 64); c.K = D; return c; } r -= I_GU;
        if (r < I_D) { const int rb = r % (D / 64), kb = r / (D / 64);
            c.src = (a.in[25]) + (size_t)(kb * 64) * (D) + (rb * 64); c.ld = D; c.dst = ((bf16*)(F.ws + WS_WD) + (size_t)(rb * 64) * DFF) + (kb * 64); c.K = DFF; return c; } r -= I_D;
        if (r < NE * I_MGU) { const int e = r / I_MGU; r %= I_MGU; const int rb = r % (2 * DFE / 64), kb = r / (2 * DFE / 64), row = rb * 64, j = row / 256, w = row % 256;
            c.src = ((w < 128 ? a.in[28] : a.in[29]) + (size_t)e * D * DFE) + (size_t)(kb * 64) * (DFE) + (128 * j + (w & 127)); c.ld = DFE; c.dst = ((bf16*)(F.ws + WS_MWGU) + ((size_t)e * 2 * DFE + row) * D) + (kb * 64); c.K = D; return c; } r -= NE * I_MGU;
        if (r < NE * I_MD) { const int e = r / I_MD; r %= I_MD; const int rb = r % (D / 64), kb = r / (D / 64);
            c.src = (a.in[30] + (size_t)e * DFE * D) + (size_t)(kb * 64) * (D) + (rb * 64); c.ld = D; c.dst = ((bf16*)(F.ws + WS_MWD) + ((size_t)e * D + rb * 64) * DFE) + (kb * 64); c.K = DFE; return c; } r -= NE * I_MD;
        if (r < 2 * I_PW) { const int l = r / I_PW; r %= I_PW; const int rb = r % (GW / 64), kb = r / (GW / 64);
            c.src = (a.in[13] + (size_t)l * GW * GW) + (size_t)(kb * 64) * (GW) + (rb * 64); c.ld = GW; c.dst = ((bf16*)(F.ws + WS_PWT) + ((size_t)l * GW + rb * 64) * GW) + (kb * 64); c.K = GW; return c; } r -= 2 * I_PW;
        { const int lg = r / I_PL; r %= I_PL; const int rb = r % 2, kb = r / 2;
            c.src = (a.in[7] + (size_t)lg * 128 * 128) + (size_t)(kb * 64) * (128) + (rb * 64); c.ld = 128; c.dst = ((bf16*)(F.ws + WS_PLT) + ((size_t)lg * 128 + rb * 64) * 128) + (kb * 64); c.K = 128; }
        return c;
}
constexpr int I_M0 = 2 * I_IN + 2 * I_OUT + I_GU + I_D, I_M1 = I_M0 + NE * I_MGU + NE * I_MD;
__device__ __forceinline__ void conv_items(const Frame& F, const Args& a, int lo, int hi, int skip0, int skip1, int gw, int NGW, LAS bf16* scr, int lane) {
    const int n = (hi - lo) - (skip1 - skip0);
    for (int it = gw; it < n; it += 2 * NGW) {
        const bool v1 = it + NGW < n; int i0 = hi - 1 - it, i1 = hi - 1 - (v1 ? it + NGW : it);
        if (i0 < skip1) i0 -= (skip1 - skip0); if (i1 < skip1) i1 -= (skip1 - skip0);
        const CItem c0 = conv_decode(F, a, i0), c1 = conv_decode(F, a, i1);
        float t0[64], t1[64];
        conv_load(c0, t0, lane); if (v1) conv_load(c1, t1, lane);
        conv_store(c0, t0, scr, lane); if (v1) conv_store(c1, t1, scr, lane); }
}
constexpr int IR_IN0 = 0, IR_IN1 = I_IN, IR_OUT0 = 2 * I_IN, IR_OUT1 = 2 * I_IN + I_OUT, IR_GU = 2 * I_IN + 2 * I_OUT, IR_MIX = I_M1;
__device__ __forceinline__ void weight_copies(const Frame& F, const Args& a, int lo, int hi) {
    PHASE_IDS;
    __syncthreads();
    LAS bf16* scr = (LAS bf16*)(F.lds + RING_OFF + 8192 + wave * 8704);
    conv_items(F, a, lo, hi, hi, hi, F.bid * NWAVES + wave, F.G * NWAVES, scr, lane);
}
constexpr int CW_Q = 1024  , CW_DONE = 1280  ;
constexpr int Q_FFN = 0, Q_MOE = 1, Q_WIN1 = 2;
__device__ __forceinline__ int q_lo(int q) { return q == Q_FFN ? IR_GU : q == Q_MOE ? I_M0 : IR_IN1; }
__device__ __forceinline__ int q_hi(int q) { return q == Q_FFN ? I_M0 : q == Q_MOE ? I_M1 : 2 * I_IN; }
__device__ __forceinline__ void converter(const Frame& F, const Args& a, int qa, int qb, int cp) {
#ifdef CV_IDLE
    return;
#endif
    PHASE_IDS;
    unsigned* ctl = (unsigned*)(F.ws + WS_CTL); unsigned* done = ctl + CW_DONE + 64 * cp;
    LAS bf16* scr = (LAS bf16*)(F.lds + RING_OFF + 8192 + wave * 8704);
    for (int qi = 0; qi < 2; ++qi) { const int q = qi ? qb : qa; if (q < 0) continue;
        unsigned* ctr = ctl + CW_Q + 64 * q; const int lo = q_lo(q), hi = q_hi(q);
        for (;;) {
            if (__builtin_amdgcn_readfirstlane((int)xb_ld(done)) != 0) return;
            int it = 0; if (lane == 0) it = (int)xb_add(ctr, 2u);
            it = __builtin_amdgcn_readfirstlane(it) + lo; if (it >= hi) break;
            const bool v1 = it + 1 < hi;
            const CItem c0 = conv_decode(F, a, it), c1 = conv_decode(F, a, v1 ? it + 1 : it);
            float t0[64], t1[64];
            conv_load(c0, t0, lane); if (v1) conv_load(c1, t1, lane);
            conv_store<true>(c0, t0, scr, lane); if (v1) conv_store<true>(c1, t1, scr, lane); } }
}
__device__ __forceinline__ void weight_rest(const Frame& F, const Args& a, int q) {
    PHASE_IDS;
    __syncthreads();
    const int lo = q_lo(q), hi = q_hi(q); const unsigned got = xb_ld((unsigned*)(F.ws + WS_CTL) + CW_Q + 64 * q);
    const int P = __builtin_amdgcn_readfirstlane(lo + (int)(got < (unsigned)(hi - lo) ? got : (unsigned)(hi - lo)));
    LAS bf16* scr = (LAS bf16*)(F.lds + RING_OFF + 8192 + wave * 8704);
    conv_items(F, a, P, hi, hi, hi, F.bid * NWAVES + wave, F.G * NWAVES, scr, lane);
}
#ifndef NCV_G1
#define NCV_G1 40
#endif
#ifndef NCV_G3
#define NCV_G3 16
#endif
__device__ __forceinline__ void p0_prologue(const Frame& F, const Args& a) {
    PHASE_IDS;
    const int gw = F.bid * NWAVES + wave, NGW = F.G * NWAVES;
    { LAS float* SC = (LAS float*)(F.lds + RING_OFF + 81920);
        const float* cvec = a.in[1]; const float* ada_w = a.in[17]; float* PART = (float*)(F.ws + WS_PART);
        for (int i = tid; i < 4 * D; i += NTHR) SC[i] = siluf_(cvec[i]);
        __syncthreads();
        for (int it = gw; it < 2 * 16 * (D6 / 64); it += NGW) { const int l = it / (16 * (D6 / 64)), rem = it % (16 * (D6 / 64)), kr = rem / (D6 / 64), cg = rem % (D6 / 64);
            const float* w = ada_w + (size_t)l * D * D6 + (size_t)(128 * kr) * D6 + cg * 64 + lane; const LAS float* sc = SC + 128 * kr;
            float a0 = 0.f, a1 = 0.f, a2 = 0.f, a3 = 0.f;
#pragma unroll 32
            for (int k = 0; k < 128; ++k) { const float wv = __builtin_nontemporal_load(w + (size_t)k * D6); a0 += sc[k] * wv; a1 += sc[D + k] * wv; a2 += sc[2 * D + k] * wv; a3 += sc[3 * D + k] * wv; }
            float* pp = PART + ((size_t)(l * 16 + kr) * 4) * D6 + cg * 64 + lane; pp[0] = a0; pp[D6] = a1; pp[2 * (size_t)D6] = a2; pp[3 * (size_t)D6] = a3; } }
    LAS bf16* scr = (LAS bf16*)(F.lds + RING_OFF + 8192 + wave * 8704);
    conv_items(F, a, IR_IN0, IR_IN1, IR_IN1, IR_IN1, gw, NGW, scr, lane);
    conv_items(F, a, IR_MIX, NITEMS, NITEMS, NITEMS, gw, NGW, scr, lane);
}

__device__ __forceinline__ void stage_w8(int tid, const float* __restrict__ src, int ld, LAS float* dst) {
    for (int d = tid; d < D; d += NTHR) { const f32x4 w0 = *(const f32x4*)(src + (size_t)d * ld), w1 = *(const f32x4*)(src + (size_t)d * ld + 4);
        dst[0 * D + d] = w0.x; dst[1 * D + d] = w0.y; dst[2 * D + d] = w0.z; dst[3 * D + d] = w0.w; dst[4 * D + d] = w1.x; dst[5 * D + d] = w1.y; dst[6 * D + d] = w1.z; dst[7 * D + d] = w1.w; }
}
__device__ __forceinline__ void dots8(const f32x4 (&u)[8], const LAS float* wt, int lane, float (&acc)[8]) {
#pragma unroll
    for (int e = 0; e < 8; ++e) { float s = 0.f;
#pragma unroll
        for (int j = 0; j < 8; ++j) { const f32x4 w = *(const LAS f32x4*)(wt + e * D + 4 * lane + 256 * j); s += u[j].x * w.x + u[j].y * w.y + u[j].z * w.z + u[j].w * w.w; }
        acc[e] = wave_sum(s); asm volatile("" ::: "memory"); }
}
__device__ __forceinline__ void store_u_bf16(bf16* urow, const f32x4 (&u)[8], int lane) {
#pragma unroll
    for (int j = 0; j < 8; ++j) { v2u o; o.x = pk2(u[j].x, u[j].y); o.y = pk2(u[j].z, u[j].w); *(v2u*)(urow + 4 * lane + 256 * j) = o; }
}
__device__ __forceinline__ void modulate(f32x4 (&u)[8], const f32x4 (&x)[8], const float* __restrict__ sh, const float* __restrict__ sc, int lane) {
#pragma unroll
    for (int j = 0; j < 8; ++j) { const f32x4 s = *(const f32x4*)(sc + 4 * lane + 256 * j), h = *(const f32x4*)(sh + 4 * lane + 256 * j); u[j] = x[j] * (s + 1.0f) + h; }
}
__device__ __forceinline__ void ln_row(f32x4 (&v)[8], const float* __restrict__ lw, const float* __restrict__ lb, int lane, float& mean_o, float& rs_o) {
    float s = 0.f;
#pragma unroll
    for (int j = 0; j < 8; ++j) s += (v[j].x + v[j].y) + (v[j].z + v[j].w);
    const float mean = wave_sum(s) * (1.f / D); float q = 0.f;
#pragma unroll
    for (int j = 0; j < 8; ++j) { v[j] = v[j] - mean; q += (v[j].x * v[j].x + v[j].y * v[j].y) + (v[j].z * v[j].z + v[j].w * v[j].w); }
    const float rs = rsqrtf(wave_sum(q) * (1.f / D) + EPS); mean_o = mean; rs_o = rs;
#pragma unroll
    for (int j = 0; j < 8; ++j) { const f32x4 w = *(const f32x4*)(lw + 4 * lane + 256 * j), b = *(const f32x4*)(lb + 4 * lane + 256 * j); v[j] = v[j] * rs * w + b; }
}
__device__ __forceinline__ void ln_center(f32x4 (&v)[8], float& mean_o, float& rs_o) {
    float s = 0.f;
#pragma unroll
    for (int j = 0; j < 8; ++j) s += (v[j].x + v[j].y) + (v[j].z + v[j].w);
    const float mean = wave_sum(s) * (1.f / D); float q = 0.f;
#pragma unroll
    for (int j = 0; j < 8; ++j) { v[j] = v[j] - mean; q += (v[j].x * v[j].x + v[j].y * v[j].y) + (v[j].z * v[j].z + v[j].w * v[j].w); }
    mean_o = mean; rs_o = rsqrtf(wave_sum(q) * (1.f / D) + EPS);
}
__device__ __forceinline__ void stage_ab(int tid, const float* __restrict__ lw, const float* __restrict__ lb, const float* __restrict__ sh, const float* __restrict__ sc, LAS float* AV, LAS float* BV) {
    for (int d = tid * 4; d < D; d += NTHR * 4) { const f32x4 w = *(const f32x4*)(lw + d), b = *(const f32x4*)(lb + d), h = *(const f32x4*)(sh + d), c = *(const f32x4*)(sc + d) + 1.0f;
        *(LAS f32x4*)(AV + d) = w * c; *(LAS f32x4*)(BV + d) = b * c + h; }
}
__device__ __forceinline__ void row_init(const Frame& F, const Args& a) {
    PHASE_IDS;
    LAS float* wt = (LAS float*)(F.lds + RING_OFF); LAS float* ML = (LAS float*)(F.lds + RING_OFF + 65536);
    stage_w8(tid, a.in[2] + 2048, INC, wt);
    const float* PART = (const float*)(F.ws + WS_PART); const float* ada_b = a.in[18]; float* ADAw = (float*)(F.ws + WS_ADA);
    for (int idx = F.bid * NTHR + tid; idx < 2 * 4 * D6; idx += F.G * NTHR) { const int l = idx / (4 * D6), b = (idx / D6) % 4, col = idx % D6; float s = ada_b[l * D6 + col];
#pragma unroll
        for (int kr = 0; kr < 16; ++kr) s += PART[((size_t)(l * 16 + kr) * 4 + b) * D6 + col];
        ADAw[idx] = s; }
    bf16* U = (bf16*)(F.ws + WS_U); float* GT = (float*)(F.ws + WS_GATES);
    for (int ch = F.bid; ch < M / 32; ch += F.G) {
        { const int b = (ch * 32) / SEQ;
            for (int j = tid; j < 2 * D; j += NTHR) { float s = ada_b[j];
#pragma unroll
                for (int kr = 0; kr < 16; ++kr) s += PART[((size_t)kr * 4 + b) * D6 + j];
                ML[j] = s; } }
        __syncthreads();
    for (int i2 = 0; i2 < 4; i2 += 2) { f32x4 xx[2][8];
#pragma unroll
        for (int i = 0; i < 2; ++i)
#pragma unroll
            for (int j = 0; j < 8; ++j) xx[i][j] = *(const f32x4*)(a.in[0] + (size_t)(ch * 32 + wave * 4 + i2 + i) * D + 4 * lane + 256 * j);
#pragma unroll
        for (int i = 0; i < 2; ++i) { const int m = ch * 32 + wave * 4 + i2 + i;
            f32x4 x[8], u[8];
#pragma unroll
            for (int j = 0; j < 8; ++j) x[j] = xx[i][j];
#pragma unroll
            for (int j = 0; j < 8; ++j) { const f32x4 s = *(const LAS f32x4*)(ML + D + 4 * lane + 256 * j), hh = *(const LAS f32x4*)(ML + 4 * lane + 256 * j); u[j] = x[j] * (s + 1.0f) + hh; }
            store_u_bf16(U + (size_t)m * D, u, lane);
            float g[8]; dots8(u, wt, lane, g);
            if (lane == 0) { *(f32x4*)(GT + (size_t)m * 8) = (f32x4){g[0], g[1], g[2], g[3]}; *(f32x4*)(GT + (size_t)m * 8 + 4) = (f32x4){g[4], g[5], g[6], g[7]}; } } }
        __syncthreads(); }
}
__device__ __forceinline__ void row_ln1(const Frame& F, const Args& a, int l) {
    PHASE_IDS;
    LAS float* wt = (LAS float*)(F.lds + RING_OFF); LAS int* se = (LAS int*)(F.lds + RING_OFF + 65536); LAS float* AV = (LAS float*)(F.lds + RING_OFF + 66560); LAS float* BV = AV + D;
    const bool moe = (l == 1);
    if (moe) { stage_w8(tid, a.in[26], 8, wt); __syncthreads(); }
    const float* adal = (const float*)(F.ws + WS_ADA) + (size_t)l * 4 * D6; bf16* U = (bf16*)(F.ws + WS_U); float* X = (float*)(F.ws + WS_X); const bf16* T = (const bf16*)(F.ws + WS_T);
    int* tok_e = (int*)(F.ws + WS_TOKE); float* tok_w = (float*)(F.ws + WS_TOKW); int* cnt = (int*)(F.ws + WS_CNT);
    if (moe) { int* rtok = (int*)(F.ws + WS_RTOK); for (int i = F.bid * NTHR + tid; i < PAIRROWS; i += F.G * NTHR) rtok[i] = 0; }
    for (int ch = F.bid; ch < M / 32; ch += F.G) {
        { const float* adab = adal + (size_t)((ch * 32) / SEQ) * D6; stage_ab(tid, a.in[19] + l * D, a.in[20] + l * D, adab + 3 * D, adab + 4 * D, AV, BV); }
        __syncthreads();
        for (int i2 = 0; i2 < 4; i2 += 2) { f32x4 vv[2][8];
#pragma unroll
        for (int i = 0; i < 2; ++i)
#pragma unroll
            for (int j = 0; j < 8; ++j) { const v2u tw = *(const v2u*)(T + (size_t)(ch * 32 + wave * 4 + i2 + i) * D + 4 * lane + 256 * j); vv[i][j] = (f32x4){bflo(tw.x), bfhi(tw.x), bflo(tw.y), bfhi(tw.y)}; }
#pragma unroll
        for (int i = 0; i < 2; ++i) { const int tl = wave * 4 + i2 + i, m = ch * 32 + tl;
            f32x4 v[8], u[8];
#pragma unroll
            for (int j = 0; j < 8; ++j) v[j] = vv[i][j];
            float mean_, rs_; ln_center(v, mean_, rs_);
            if (lane == 0) { X[2 * (size_t)m] = mean_; X[2 * (size_t)m + 1] = rs_; }
#pragma unroll
            for (int j = 0; j < 8; ++j) u[j] = v[j] * rs_ * *(const LAS f32x4*)(AV + 4 * lane + 256 * j) + *(const LAS f32x4*)(BV + 4 * lane + 256 * j);
            store_u_bf16(U + (size_t)m * D, u, lane);
            if (moe) { float lg[8]; dots8(u, wt, lane, lg);
#pragma unroll
                for (int e = 0; e < 8; ++e) lg[e] += a.in[27][e];
                int i1 = 0; float v1 = lg[0];
#pragma unroll
                for (int e = 1; e < 8; ++e) if (lg[e] > v1) { v1 = lg[e]; i1 = e; }
                int i2 = -1; float v2 = -3.0e38f;
#pragma unroll
                for (int e = 0; e < 8; ++e) if (e != i1 && lg[e] > v2) { v2 = lg[e]; i2 = e; }
                if (i2 < 0) i2 = (i1 + 1) & 7;
                const float e2 = __expf(v2 - v1), w1 = rcpf_(1.f + e2), w2 = e2 * w1;
                if (lane == 0) { tok_e[m * 2] = i1; tok_e[m * 2 + 1] = i2; tok_w[m * 2] = w1; tok_w[m * 2 + 1] = w2; se[tl * 2] = i1; se[tl * 2 + 1] = i2; } } } }
        if (moe) { __syncthreads();
            if (tid < 8) { int c = 0; for (int t = 0; t < 32; ++t) c += (se[t * 2] == tid) + (se[t * 2 + 1] == tid); cnt[ch * 8 + tid] = c; } }
        __syncthreads(); }
}
__device__ __forceinline__ void moe_scatter(const Frame& F) {
    PHASE_IDS;
    LAS int* sh = (LAS int*)(F.lds + RING_OFF);
    const int* tok_e = (const int*)(F.ws + WS_TOKE); const int* cnt = (const int*)(F.ws + WS_CNT); int* ppos = (int*)(F.ws + WS_PPOS); int* pane = (int*)(F.ws + WS_PANE);
    int* rtok = (int*)(F.ws + WS_RTOK);
    for (int ch = F.bid; ch < M / 32; ch += F.G) {
        int tot = 0, before = 0;
        { const int e = tid & 7, sgm = tid >> 3; int pt = 0, pb = 0;
#pragma unroll
            for (int q = 0; q < 4; ++q) { const int c = sgm * 4 + q; const int v = cnt[c * 8 + e]; pt += v; if (c < ch) pb += v; }
            sh[128 + tid] = pt; sh[128 + NTHR + tid] = pb; }
        __syncthreads();
        if (tid < 8) { for (int s2 = 0; s2 < 64; ++s2) { tot += sh[128 + s2 * 8 + tid]; before += sh[128 + NTHR + s2 * 8 + tid]; } sh[tid] = tot; }
        __syncthreads();
        if (tid < 8) { int start = 0; for (int e = 0; e < tid; ++e) start += (sh[e] + 255) / 256 * 256;
            sh[8 + tid] = start + before;
            if (ch == 0) { const int p0 = start / 256, np = (tot + 255) / 256; for (int p = 0; p < np; ++p) pane[p0 + p] = tid;
                if (tid == 7) { for (int p = p0 + np; p < MAXPANEL; ++p) pane[p] = 0; pane[MAXPANEL] = p0 + np; } } }
        __syncthreads();
        if (tid >= 64 && tid < 128) sh[1300 + tid - 64] = tok_e[ch * 64 + tid - 64];
        __syncthreads();
        if (tid < 8) { int base = sh[8 + tid]; for (int pr = 0; pr < 64; ++pr) if (sh[1300 + pr] == tid) sh[16 + pr] = base++; }
        __syncthreads();
        if (tid < 64) { ppos[ch * 64 + tid] = sh[16 + tid]; rtok[sh[16 + tid]] = ch * 32 + (tid >> 1); }
        __syncthreads(); }
}
__device__ __forceinline__ void row_ln2(const Frame& F, const Args& a, int l) {
    PHASE_IDS;
    LAS float* wt = (LAS float*)(F.lds + RING_OFF); LAS float* AV = (LAS float*)(F.lds + RING_OFF + 66560); LAS float* BV = AV + D;
    if (l == 0) { stage_w8(tid, a.in[2] + (size_t)D * INC + 2048, INC, wt); __syncthreads(); }
    const float* adal = (const float*)(F.ws + WS_ADA) + (size_t)l * 4 * D6; const float* adan = adal + 4 * D6;
    bf16* U = (bf16*)(F.ws + WS_U); float* X = (float*)(F.ws + WS_X); const bf16* T = (const bf16*)(F.ws + WS_T); float* GT = (float*)(F.ws + WS_GATES);
    const int* ppos = (const int*)(F.ws + WS_PPOS); const float* tok_w = (const float*)(F.ws + WS_TOKW); const bf16* YP = (const bf16*)(F.ws + WS_PROJ);
    for (int ch = F.bid; ch < M / 32; ch += F.G) {
        if (l == 0) { __syncthreads(); { const float* adab = adan + (size_t)((ch * 32) / SEQ) * D6; stage_ab(tid, a.in[21] + l * D, a.in[22] + l * D, adab, adab + D, AV, BV); }
            __syncthreads();
            for (int i2 = 0; i2 < 4; i2 += 2) { f32x4 vv[2][8];
#pragma unroll
            for (int i = 0; i < 2; ++i)
#pragma unroll
                for (int j = 0; j < 8; ++j) { const v2u tw = *(const v2u*)(T + (size_t)(ch * 32 + wave * 4 + i2 + i) * D + 4 * lane + 256 * j); vv[i][j] = (f32x4){bflo(tw.x), bfhi(tw.x), bflo(tw.y), bfhi(tw.y)}; }
#pragma unroll
            for (int i = 0; i < 2; ++i) { const int m = ch * 32 + wave * 4 + i2 + i, b = m / SEQ; f32x4 v[8], u[8];
#pragma unroll
                for (int j = 0; j < 8; ++j) v[j] = vv[i][j];
                float mean_, rs_; ln_center(v, mean_, rs_);
                if (lane == 0) { X[2 * (size_t)m] = mean_; X[2 * (size_t)m + 1] = rs_; }
#pragma unroll
                for (int j = 0; j < 8; ++j) u[j] = v[j] * rs_ * *(const LAS f32x4*)(AV + 4 * lane + 256 * j) + *(const LAS f32x4*)(BV + 4 * lane + 256 * j);
                store_u_bf16(U + (size_t)m * D, u, lane);
                float g[8]; dots8(u, wt, lane, g);
                if (lane == 0) { *(f32x4*)(GT + (size_t)m * 8) = (f32x4){g[0], g[1], g[2], g[3]}; *(f32x4*)(GT + (size_t)m * 8 + 4) = (f32x4){g[4], g[5], g[6], g[7]}; } } }
        } else {
            LAS float* PV = (LAS float*)(F.lds + RING_OFF);
            __syncthreads();
            { const float* g2 = adal + (size_t)((ch * 32) / SEQ) * D6 + 5 * D;
                for (int d = tid * 4; d < D; d += NTHR * 4) { *(LAS f32x4*)(PV + d) = *(const f32x4*)(a.in[19] + l * D + d) * ALPHA; *(LAS f32x4*)(PV + D + d) = *(const f32x4*)(a.in[20] + l * D + d) * ALPHA;
                    *(LAS f32x4*)(PV + 2 * D + d) = *(const f32x4*)(g2 + d) + 1.0f; *(LAS f32x4*)(PV + 3 * D + d) = *(const f32x4*)(a.in[21] + l * D + d); *(LAS f32x4*)(PV + 4 * D + d) = *(const f32x4*)(a.in[22] + l * D + d); } }
            __syncthreads();
            for (int i2 = 0; i2 < 4; i2 += 2) { f32x4 xx[2][8]; v2u ya[2][8], yb[2][8]; float w1[2], w2[2];
#pragma unroll
                for (int i = 0; i < 2; ++i) { const int m = ch * 32 + wave * 4 + i2 + i; const int p1 = ppos[m * 2], p2 = ppos[m * 2 + 1]; w1[i] = tok_w[m * 2]; w2[i] = tok_w[m * 2 + 1];
#pragma unroll
                    for (int j = 0; j < 8; ++j) { const int d = 4 * lane + 256 * j; const v2u tw = *(const v2u*)(T + (size_t)m * D + d); xx[i][j] = (f32x4){bflo(tw.x), bfhi(tw.x), bflo(tw.y), bfhi(tw.y)}; ya[i][j] = *(const v2u*)(YP + (size_t)p1 * D + d); yb[i][j] = *(const v2u*)(YP + (size_t)p2 * D + d); } }
#pragma unroll
                for (int i = 0; i < 2; ++i) { const int m = ch * 32 + wave * 4 + i2 + i; f32x4 v[8]; const float mu1 = X[2 * (size_t)m], rs1 = X[2 * (size_t)m + 1];
#pragma unroll
                    for (int j = 0; j < 8; ++j) { const int d = 4 * lane + 256 * j; const v2u y1 = ya[i][j], y2 = yb[i][j];
                        f32x4 y; y.x = w1[i] * __uint_as_float(y1.x << 16) + w2[i] * __uint_as_float(y2.x << 16); y.y = w1[i] * __uint_as_float(y1.x & 0xffff0000u) + w2[i] * __uint_as_float(y2.x & 0xffff0000u);
                        y.z = w1[i] * __uint_as_float(y1.y << 16) + w2[i] * __uint_as_float(y2.y << 16); y.w = w1[i] * __uint_as_float(y1.y & 0xffff0000u) + w2[i] * __uint_as_float(y2.y & 0xffff0000u);
                        v[j] = (xx[i][j] - mu1) * rs1 * *(const LAS f32x4*)(PV + d) + *(const LAS f32x4*)(PV + D + d) + *(const LAS f32x4*)(PV + 2 * D + d) * y;
                        asm volatile("" ::: "memory"); }
                    float mean_, rs_; ln_center(v, mean_, rs_);
#pragma unroll
                    for (int j = 0; j < 8; ++j) { const int d = 4 * lane + 256 * j; *(f32x4*)(a.out + (size_t)m * D + d) = v[j] * rs_ * *(const LAS f32x4*)(PV + 3 * D + d) + *(const LAS f32x4*)(PV + 4 * D + d);
                        if (j & 1) asm volatile("" ::: "memory"); } } } } }
    __syncthreads();
}
typedef float f32x16 __attribute__((ext_vector_type(16)));
typedef short s16x8 __attribute__((ext_vector_type(8)));
__device__ __forceinline__ int crow(int r, int hi) { return (r & 3) + 8 * (r >> 2) + 4 * hi; }
__device__ __forceinline__ s16x8 ld8(const LAS bf16* p) { return *(const LAS s16x8*)p; }
__device__ __forceinline__ s16x8 ld8g(const bf16* p) { return *(const s16x8*)p; }
template <int K> __device__ __forceinline__ void mma_ll(f32x16& acc, const LAS bf16* A, int lda, const LAS bf16* B, int ldb, int lane) {
    const int r = lane & 31, ko = 8 * (lane >> 5);
#pragma unroll
    for (int k = 0; k < K; k += 16) acc = __builtin_amdgcn_mfma_f32_32x32x16_bf16(ld8(A + r * lda + k + ko), ld8(B + r * ldb + k + ko), acc, 0, 0, 0);
}
__device__ __forceinline__ int swz(int row, int s) { return (((s >> 3) ^ ((row >> 3) & 7)) << 3) | (s & 7); }
template <int K, bool SWA, bool SWB> __device__ __forceinline__ void mma_ll_sw(f32x16& acc, const LAS bf16* A, int lda, int rowA0, const LAS bf16* B, int ldb, int rowB0, int lane) {
    const int r = lane & 31, hi = lane >> 5, ra = rowA0 + r, rb = rowB0 + r;
#pragma unroll
    for (int k = 0; k < K; k += 16) { const int g = (k >> 3) + hi;
        const int ca = SWA ? ((g ^ ((ra >> 3) & 7)) << 3) : (g << 3), cb = SWB ? ((g ^ ((rb >> 3) & 7)) << 3) : (g << 3);
        acc = __builtin_amdgcn_mfma_f32_32x32x16_bf16(ld8(A + ra * lda + ca), ld8(B + rb * ldb + cb), acc, 0, 0, 0); }
}
template <int K> __device__ __forceinline__ void mma_lg(f32x16& acc, const LAS bf16* A, int lda, const bf16* B, int ldb, int lane) {
    const int r = lane & 31, ko = 8 * (lane >> 5);
#pragma unroll
    for (int k = 0; k < K; k += 16) acc = __builtin_amdgcn_mfma_f32_32x32x16_bf16(ld8(A + r * lda + k + ko), ld8g(B + (size_t)r * ldb + k + ko), acc, 0, 0, 0);
}
template <int K> __device__ __forceinline__ void mma_gg(f32x16& acc, const bf16* A, int lda, const bf16* B, int ldb, int lane) {
    const int r = lane & 31, ko = 8 * (lane >> 5);
#pragma unroll
    for (int k = 0; k < K; k += 16) acc = __builtin_amdgcn_mfma_f32_32x32x16_bf16(ld8g(A + (size_t)r * lda + k + ko), ld8g(B + (size_t)r * ldb + k + ko), acc, 0, 0, 0);
}
__device__ __forceinline__ f32x16 zero16() { f32x16 z;
#pragma unroll
    for (int i = 0; i < 16; ++i) z[i] = 0.f; return z; }
__device__ __forceinline__ void rms_tile_to_ycat(const LAS float* Y, const float* __restrict__ gw, bf16* __restrict__ YCAT, int m0, int coff, int wave, int lane) {
    for (int i = 0; i < 4; ++i) { const int t = wave * 4 + i; const f32x4 v0 = *(const LAS f32x4*)(Y + t * 512 + lane * 8), v1 = *(const LAS f32x4*)(Y + t * 512 + lane * 8 + 4);
        const float ss = (v0.x * v0.x + v0.y * v0.y) + (v0.z * v0.z + v0.w * v0.w) + (v1.x * v1.x + v1.y * v1.y) + (v1.z * v1.z + v1.w * v1.w);
        const float rs = rsqrtf(wave_sum(ss) * (1.f / 512.f) + EPS);
        const f32x4 g0 = *(const f32x4*)(gw + lane * 8), g1 = *(const f32x4*)(gw + lane * 8 + 4);
        v4u o; o.x = pk2(v0.x * rs * g0.x, v0.y * rs * g0.y); o.y = pk2(v0.z * rs * g0.z, v0.w * rs * g0.w); o.z = pk2(v1.x * rs * g1.x, v1.y * rs * g1.y); o.w = pk2(v1.z * rs * g1.z, v1.w * rs * g1.w);
        *(v4u*)(YCAT + (size_t)(m0 + t) * D + coff + lane * 8) = o; }
}
__device__ __forceinline__ void mix_conv(const Frame& F, const Args& a, int l, int tile) {
    PHASE_IDS;
    const int m0 = tile * 32, t0 = m0 % SEQ;
    LAS bf16* HI = (LAS bf16*)(F.lds);
    LAS float* CV = (LAS float*)(F.lds + 63488);
    LAS bf16* CL = (LAS bf16*)(F.lds);
    const bf16* PROJ = (const bf16*)(F.ws + WS_PROJ); bf16* YCAT = (bf16*)(F.ws + WS_YCAT);
    float w[31]; const float dwb = a.in[10][l * GW + tid];
    { const float* dw = a.in[9] + (size_t)l * 31 * GW + tid;
#pragma unroll
        for (int j = 0; j < 31; ++j) w[j] = dw[j * GW]; }
#pragma unroll
    for (int it = 0; it < 8; ++it) { const int i = tid + it * NTHR; if (i >= 62 * 64) break; const int tt = i >> 6, c8 = (i & 63) * 8;
        v4u o = (v4u){0u, 0u, 0u, 0u};
        if (t0 - 30 + tt >= 0) { const bf16* p = PROJ + (size_t)(m0 - 30 + tt) * PC + C_CONV + c8; const v4u av = *(const v4u*)p, gv = *(const v4u*)(p + 512);
#pragma unroll
            for (int j = 0; j < 4; ++j) o[j] = pk2(bflo(av[j]) * sigmoidf_(bflo(gv[j])), bfhi(av[j]) * sigmoidf_(bfhi(gv[j]))); }
        *(LAS v4u*)(HI + tt * 512 + c8) = o; }
    __syncthreads();
    { const int c = tid; float acc[32]; const float bias = dwb;
#pragma unroll
        for (int t = 0; t < 32; ++t) acc[t] = bias;
#pragma unroll
        for (int tt = 0; tt < 62; ++tt) { const float hv = bf2f(HI[tt * 512 + c]);
#pragma unroll
            for (int t = 0; t < 32; ++t) { const int j = tt - t; if (j >= 0 && j <= 30) acc[t] += w[j] * hv; } }
#pragma unroll
        for (int t = 0; t < 32; ++t) CV[t * 512 + c] = acc[t]; }
    __syncthreads();
    { const float* lw = a.in[11] + l * GW + lane * 8; const float* lb = a.in[12] + l * GW + lane * 8;
        for (int i = 0; i < 4; ++i) { const int t = wave * 4 + i; f32x4 v0 = *(const LAS f32x4*)(CV + t * 512 + lane * 8), v1 = *(const LAS f32x4*)(CV + t * 512 + lane * 8 + 4);
            const float mean = wave_sum((v0.x + v0.y) + (v0.z + v0.w) + (v1.x + v1.y) + (v1.z + v1.w)) * (1.f / 512.f); v0 = v0 - mean; v1 = v1 - mean;
            const float rs = rsqrtf(wave_sum((v0.x * v0.x + v0.y * v0.y) + (v0.z * v0.z + v0.w * v0.w) + (v1.x * v1.x + v1.y * v1.y) + (v1.z * v1.z + v1.w * v1.w)) * (1.f / 512.f) + EPS);
            const f32x4 w0 = *(const f32x4*)lw, w1 = *(const f32x4*)(lw + 4), b0 = *(const f32x4*)lb, b1 = *(const f32x4*)(lb + 4);
            v0 = v0 * rs * w0 + b0; v1 = v1 * rs * w1 + b1;
            v4u o; o.x = pk2(siluf_(v0.x), siluf_(v0.y)); o.y = pk2(siluf_(v0.z), siluf_(v0.w)); o.z = pk2(siluf_(v1.x), siluf_(v1.y)); o.w = pk2(siluf_(v1.z), siluf_(v1.w));
            *(LAS v4u*)(CL + t * 520 + lane * 8) = o; } }
    __syncthreads();
    { const bf16* PWT = (const bf16*)(F.ws + WS_PWT) + (size_t)l * GW * GW; const int hi = lane >> 5, r = lane & 31;
        LAS bf16* BS = (LAS bf16*)(F.lds + 33280);
        v4u pre[8]; f32x16 acc[2]; acc[0] = zero16(); acc[1] = zero16();
        const int krot = F.bid & 7;
#pragma unroll
        for (int q = 0; q < 8; ++q) { const int p = tid + NTHR * q; pre[q] = *(const v4u*)(PWT + (size_t)(p >> 3) * GW + 64 * krot + 8 * (p & 7)); }
        for (int kc0 = 0; kc0 < 8; ++kc0) { const int kc = (kc0 + krot) & 7, kn = (kc0 + 1 + krot) & 7;
#pragma unroll
            for (int q = 0; q < 8; ++q) { const int p = tid + NTHR * q; *(LAS v4u*)(BS + (p >> 3) * 72 + 8 * (p & 7)) = pre[q]; }
            __syncthreads();
            if (kc0 < 7) {
#pragma unroll
                for (int q = 0; q < 8; ++q) { const int p = tid + NTHR * q; pre[q] = *(const v4u*)(PWT + (size_t)(p >> 3) * GW + 64 * kn + 8 * (p & 7)); } }
#pragma unroll
            for (int q = 0; q < 2; ++q)
#pragma unroll
                for (int kk = 0; kk < 4; ++kk) acc[q] = __builtin_amdgcn_mfma_f32_32x32x16_bf16(ld8(CL + r * 520 + 64 * kc + 16 * kk + 8 * hi), ld8(BS + ((wave * 2 + q) * 32 + r) * 72 + 16 * kk + 8 * hi), acc[q], 0, 0, 0);
            __syncthreads(); }
#pragma unroll
        for (int q = 0; q < 2; ++q) { const int n = (wave * 2 + q) * 32 + r; const float bv = a.in[14][l * GW + n];
#pragma unroll
            for (int rr = 0; rr < 16; ++rr) CV[crow(rr, hi) * 512 + n] = acc[q][rr] + bv; } }
    __syncthreads();
    rms_tile_to_ycat(CV, a.in[15] + l * 3 * GW + 2 * GW, YCAT, m0, 1536, wave, lane);
    __syncthreads();
}
__device__ __forceinline__ void mix_pool(const Frame& F, const Args& a, int l, int tile) {
    PHASE_IDS;
    const int m0 = tile * 32, t0 = m0 % SEQ;
    LAS bf16* PI = (LAS bf16*)(F.lds);
    LAS float* YB = (LAS float*)(F.lds + 33280);
    const bf16* PROJ = (const bf16*)(F.ws + WS_PROJ); bf16* YCAT = (bf16*)(F.ws + WS_YCAT);
    const bf16* PLT = (const bf16*)(F.ws + WS_PLT) + (size_t)l * 4 * 128 * 128; s16x8 wfr[2][8]; float psc[2];
#pragma unroll
    for (int q = 0; q < 2; ++q) { const int idx = wave * 2 + q, g = idx >> 2, nb = idx & 3; psc[q] = a.in[8][l * GW + g * 128 + nb * 32 + (lane & 31)];
#pragma unroll
        for (int k = 0; k < 8; ++k) wfr[q][k] = ld8g(PLT + ((size_t)g * 128 + nb * 32 + (lane & 31)) * 128 + 16 * k + 8 * (lane >> 5)); }
    LAS bf16* RAW = (LAS bf16*)(F.lds + 33280);
#pragma unroll
    for (int it = 0; it < 6; ++it) { const int i = tid + it * NTHR; if (i >= 47 * 64) break; const int rr = i >> 6, c8 = (i & 63) * 8;
        if (t0 - 15 + rr >= 0) *(LAS v4u*)(RAW + rr * 512 + c8) = *(const v4u*)(PROJ + (size_t)(m0 - 15 + rr) * PC + C_POOL + c8); }
    __syncthreads();
    for (int i = tid; i < 32 * 64; i += NTHR) { const int t = i >> 6, c8 = (i & 63) * 8, g = c8 >> 7, win = 2 << g; const int ta = t0 + t; const int n = (ta + 1 < win) ? ta + 1 : win;
        float s[8], cur[8];
#pragma unroll
        for (int j = 0; j < 8; ++j) { s[j] = 0.f; cur[j] = 0.f; }
#pragma unroll
        for (int j = 0; j < 16; ++j) { v4u rv = (v4u){0u, 0u, 0u, 0u}; if (j < n) rv = *(const LAS v4u*)(RAW + (15 + t - j) * 512 + c8);
#pragma unroll
            for (int q = 0; q < 4; ++q) { s[2 * q] += bflo(rv[q]); s[2 * q + 1] += bfhi(rv[q]); if (j == 0) { cur[2 * q] = bflo(rv[q]); cur[2 * q + 1] = bfhi(rv[q]); } } }
        const float inv = rcpf_((float)n); v4u o;
#pragma unroll
        for (int q = 0; q < 4; ++q) o[q] = pk2(s[2 * q] * inv - cur[2 * q], s[2 * q + 1] * inv - cur[2 * q + 1]);
        *(LAS v4u*)(PI + t * 520 + c8) = o; }
    __syncthreads();
    { const int hi = lane >> 5;
#pragma unroll
        for (int q = 0; q < 2; ++q) { const int idx = wave * 2 + q, g = idx >> 2, nb = idx & 3; f32x16 acc = zero16();
#pragma unroll
            for (int k = 0; k < 8; ++k) acc = __builtin_amdgcn_mfma_f32_32x32x16_bf16(ld8(PI + (lane & 31) * 520 + g * 128 + 16 * k + 8 * hi), wfr[q][k], acc, 0, 0, 0);
            const int n = g * 128 + nb * 32 + (lane & 31);
#pragma unroll
            for (int r = 0; r < 16; ++r) YB[crow(r, hi) * 512 + n] = acc[r] * psc[q]; } }
    __syncthreads();
    rms_tile_to_ycat(YB, a.in[15] + l * 3 * GW, YCAT, m0, 512, wave, lane);
    __syncthreads();
}
__device__ __forceinline__ void mix_sb_unit(const Frame& F, const Args& a, int l, LAS unsigned char* wl, int unit, int dh, int wave, int lane) {
    const int qb = unit & 63, bh = unit >> 6, b = bh >> 2, h = bh & 3; const int mq = b * SEQ + qb * 32, hi = lane >> 5, t = lane & 31;
    LAS bf16* VT = (LAS bf16*)wl;
    const bf16* PROJ = (const bf16*)(F.ws + WS_PROJ); bf16* YCAT = (bf16*)(F.ws + WS_YCAT);
    const bf16* Qp = PROJ + (size_t)(mq + t) * PC + C_SB + h * 128 + 8 * hi;
    s16x8 qf[8];
#pragma unroll
    for (int k = 0; k < 8; ++k) qf[k] = ld8g(Qp + 16 * k);
    f32x16 O[2]; O[0] = zero16(); O[1] = zero16();
    float P = 1.f;
    for (int kb = qb; kb >= 0; --kb) {
        const bf16* Kp = PROJ + (size_t)(b * SEQ + kb * 32) * PC + C_SB + 512 + h * 128; const bf16* Vp = Kp + 512 + dh * 64;
        f32x16 S = zero16();
#pragma unroll
        for (int k = 0; k < 8; ++k) S = __builtin_amdgcn_mfma_f32_32x32x16_bf16(ld8g(Kp + (size_t)t * PC + 16 * k + 8 * hi), qf[k], S, 0, 0, 0);
#pragma unroll
        for (int i = 0; i < 4; ++i) { const int idx = lane + 64 * i, s = idx >> 3, d8 = (idx & 7) * 8; const v4u vv = *(const v4u*)(Vp + (size_t)s * PC + d8);
#pragma unroll
            for (int q = 0; q < 4; ++q) { const int d0 = d8 + 2 * q, c0 = (((s >> 3) ^ ((d0 >> 3) & 3)) << 3) | (s & 7);
                VT[d0 * 40 + c0] = (bf16)(vv[q] & 0xffffu); VT[(d0 + 1) * 40 + c0] = (bf16)(vv[q] >> 16); } }
        float beta[16], keep[16];
#pragma unroll
        for (int r = 0; r < 16; ++r) { const bool valid = (kb < qb) || (crow(r, hi) < t);
            const float z = fminf(fmaxf(S[r] * 0.088388347648318447f, -80.f), 80.f); const float e = __expf(-z), bt = rcpf_(1.f + e);
            beta[r] = valid ? bt : 0.f; keep[r] = valid ? e * bt : 1.f; }
        float gp[4], pg[4];
#pragma unroll
        for (int j = 0; j < 4; ++j) { gp[j] = (keep[4 * j] * keep[4 * j + 1]) * (keep[4 * j + 2] * keep[4 * j + 3]); pg[j] = __shfl_xor(gp[j], 32); }
        float so[4], sp[4]; so[3] = 1.f; so[2] = gp[3]; so[1] = gp[3] * gp[2]; so[0] = so[1] * gp[1];
        sp[3] = 1.f; sp[2] = pg[3]; sp[1] = pg[3] * pg[2]; sp[0] = sp[1] * pg[1];
        float av[16];
#pragma unroll
        for (int j = 0; j < 4; ++j) { const float ga = P * so[j] * (hi ? sp[j] : sp[j] * pg[j]);
            const float k3 = keep[4 * j + 3], k23 = k3 * keep[4 * j + 2], k123 = k23 * keep[4 * j + 1];
            av[4 * j + 3] = beta[4 * j + 3] * ga; av[4 * j + 2] = beta[4 * j + 2] * ga * k3; av[4 * j + 1] = beta[4 * j + 1] * ga * k23; av[4 * j] = beta[4 * j] * ga * k123; }
        P = P * (so[0] * gp[0]) * (sp[0] * pg[0]);
        s16x8 pb[2];
#pragma unroll
        for (int s2 = 0; s2 < 2; ++s2) { v4u w; w.x = pk2(av[8 * s2], av[8 * s2 + 1]); w.y = pk2(av[8 * s2 + 2], av[8 * s2 + 3]); w.z = pk2(av[8 * s2 + 4], av[8 * s2 + 5]); w.w = pk2(av[8 * s2 + 6], av[8 * s2 + 7]);
            pb[s2] = __builtin_bit_cast(s16x8, w); }
        LDS_WAIT();
#pragma unroll
        for (int db = 0; db < 2; ++db)
#pragma unroll
            for (int s2 = 0; s2 < 2; ++s2) { const int dr = db * 32 + t, key = (dr >> 3) & 3; const LAS bf16* vrow = VT + dr * 40 + 4 * hi;
                const v2u lo = *(const LAS v2u*)(vrow + (((2 * s2) ^ key) << 3)), hi2 = *(const LAS v2u*)(vrow + (((2 * s2 + 1) ^ key) << 3)); v4u w; w.x = lo.x; w.y = lo.y; w.z = hi2.x; w.w = hi2.y;
                O[db] = __builtin_amdgcn_mfma_f32_32x32x16_bf16(__builtin_bit_cast(s16x8, w), pb[s2], O[db], 0, 0, 0); }
        LDS_WAIT();
        if (wave_max(P) < 1e-12f) break;
    }
    LAS float* SSQ = (LAS float*)(F.lds + 65536);
    float ss = 0.f;
#pragma unroll
    for (int db = 0; db < 2; ++db)
#pragma unroll
        for (int r = 0; r < 16; ++r) ss += O[db][r] * O[db][r];
    ss += __shfl_xor(ss, 32);
    if (hi == 0) SSQ[wave * 32 + t] = ss;
    __syncthreads();
    float tot = 0.f;
#pragma unroll
    for (int w8 = 0; w8 < 8; ++w8) tot += SSQ[w8 * 32 + t];
    const float rs = rsqrtf(tot * (1.f / 512.f) + EPS);
    const float* gw = a.in[15] + l * 3 * GW + GW + h * 128 + dh * 64 + 4 * hi;
#pragma unroll
    for (int db = 0; db < 2; ++db)
#pragma unroll
        for (int g4 = 0; g4 < 4; ++g4) { const f32x4 g = *(const f32x4*)(gw + db * 32 + 8 * g4);
            v2u o; o.x = pk2(O[db][4 * g4] * rs * g.x, O[db][4 * g4 + 1] * rs * g.y); o.y = pk2(O[db][4 * g4 + 2] * rs * g.z, O[db][4 * g4 + 3] * rs * g.w);
            *(v2u*)(YCAT + (size_t)(mq + t) * D + 1024 + h * 128 + dh * 64 + db * 32 + 8 * g4 + 4 * hi) = o; }
    __syncthreads();
}
__device__ __forceinline__ void conv4_silu8(const bf16* PROJ, int m, int t, int ch, const float* __restrict__ cw, const float* __restrict__ cb, float (&o)[8]) {
    const f32x4 b0 = *(const f32x4*)(cb + ch), b1 = *(const f32x4*)(cb + ch + 4);
    o[0] = b0.x; o[1] = b0.y; o[2] = b0.z; o[3] = b0.w; o[4] = b1.x; o[5] = b1.y; o[6] = b1.z; o[7] = b1.w;
#pragma unroll
    for (int j = 0; j < 4; ++j) if (t - 3 + j >= 0) { const v4u pv = *(const v4u*)(PROJ + (size_t)(m - 3 + j) * PC + C_QK + ch);
        const f32x4 w0 = *(const f32x4*)(cw + j * 1024 + ch), w1 = *(const f32x4*)(cw + j * 1024 + ch + 4);
        o[0] += w0.x * bflo(pv[0]); o[1] += w0.y * bfhi(pv[0]); o[2] += w0.z * bflo(pv[1]); o[3] += w0.w * bfhi(pv[1]);
        o[4] += w1.x * bflo(pv[2]); o[5] += w1.y * bfhi(pv[2]); o[6] += w1.z * bflo(pv[3]); o[7] += w1.w * bfhi(pv[3]); }
#pragma unroll
    for (int j = 0; j < 8; ++j) o[j] = siluf_(o[j]);
}
constexpr size_t WSM_DC = WS_NAIVE + (size_t)M * GW * 2;
constexpr size_t WSM_CS = WSM_DC + (size_t)NUNIT * STATE * 4;
constexpr size_t WSM_GA = WSM_CS + (size_t)NUNIT * STATE * 2;
constexpr size_t WSM_MS = WSM_GA + 4096;
constexpr size_t WSM_BB = WSM_MS + 4096;
constexpr size_t WSM_AL = WSM_BB + (size_t)NBH * SEQ * 4;
constexpr size_t WSM_END = WSM_AL + (size_t)NBH * SEQ * 4;
__device__ __forceinline__ void mix_mlstm_a(const Frame& F, const Args& a, int l, int unit) {
    PHASE_IDS;
    LAS bf16* KWT = (LAS bf16*)(F.lds);
    LAS bf16* VT = (LAS bf16*)(F.lds + 18432);
    LAS float* sw = (LAS float*)(F.lds + 36864);
    const int bh = unit / NCHUNK, c = unit % NCHUNK, b = bh >> 2, h = bh & 3, t0 = c * CH, m0 = b * SEQ + t0;
    const bf16* PROJ = (const bf16*)(F.ws + WS_PROJ); const float* GT = (const float*)(F.ws + WS_GATES);
    float* DC = (float*)(F.ws + WSM_DC) + (size_t)unit * STATE; float* GA = (float*)(F.ws + WSM_GA); float* BB = (float*)(F.ws + WSM_BB); float* AL = (float*)(F.ws + WSM_AL);
    if (wave == 0) { const float* gb = a.in[5] + l * 8;
        const float ip = GT[(size_t)(m0 + lane) * 8 + h] + gb[h], fp = GT[(size_t)(m0 + lane) * 8 + 4 + h] + gb[4 + h];
        float lf = logsigmoidf_(fp);
#pragma unroll
        for (int o = 1; o < 64; o <<= 1) { const float n = __shfl_up(lf, o); if (lane >= o) lf += n; }
        const float g = __shfl(lf, 63), av = g - lf + ip, amax = wave_max(av);
        sw[lane] = __expf(av - amax); BB[(size_t)bh * SEQ + t0 + lane] = lf; AL[(size_t)bh * SEQ + t0 + lane] = ip - lf;
        if (lane == 0) { GA[unit * 2] = g; GA[unit * 2 + 1] = amax; } }
    __syncthreads();
    const float* cw = a.in[3] + l * 4 * 1024; const float* cb = a.in[4] + l * 1024;
#pragma unroll
    for (int i = tid; i < 64 * 16; i += NTHR) { const int s = i >> 4, d8 = (i & 15) * 8; float kv[8];
        conv4_silu8(PROJ, m0 + s, t0 + s, 512 + h * 128 + d8, cw, cb, kv); const float w = sw[s];
        const v4u vv = *(const v4u*)(PROJ + (size_t)(m0 + s) * PC + C_V + h * 128 + d8);
#pragma unroll
        for (int j = 0; j < 8; ++j) KWT[(d8 + j) * 72 + swz(d8 + j, s)] = (bf16)f2bf(kv[j] * w);
#pragma unroll
        for (int q = 0; q < 4; ++q) { VT[(d8 + 2 * q) * 72 + swz(d8 + 2 * q, s)] = (bf16)(vv[q] & 0xffffu); VT[(d8 + 2 * q + 1) * 72 + swz(d8 + 2 * q + 1, s)] = (bf16)(vv[q] >> 16); } }
    __syncthreads();
    { const int hi = lane >> 5;
        for (int q = 0; q < 2; ++q) { const int idx = wave * 2 + q, eb = idx >> 2, nb = idx & 3; f32x16 acc = zero16();
            mma_ll_sw<64, true, true>(acc, VT, 72, eb * 32, KWT, 72, nb * 32, lane);
#pragma unroll
            for (int r = 0; r < 16; ++r) DC[(eb * 32 + crow(r, hi)) * 128 + nb * 32 + (lane & 31)] = acc[r]; } }
    if (tid < 128) { float s = 0.f; for (int j = 0; j < 64; ++j) s += bf2f(KWT[tid * 72 + j]); DC[128 * 128 + tid] = s; }
    __syncthreads();
}
__device__ __forceinline__ void mix_scan(const Frame& F) {
    PHASE_IDS;
    const float* DC = (const float*)(F.ws + WSM_DC); const float* GA = (const float*)(F.ws + WSM_GA); bf16* CS = (bf16*)(F.ws + WSM_CS); float* MS = (float*)(F.ws + WSM_MS);
    LAS float* TB = (LAS float*)(F.lds + RING_OFF);
    if (tid < NBH) { const int bh = tid; float gg[NCHUNK], am[NCHUNK];
#pragma unroll
        for (int c = 0; c < NCHUNK; ++c) { gg[c] = GA[(bh * NCHUNK + c) * 2]; am[c] = GA[(bh * NCHUNK + c) * 2 + 1]; }
        float m = 0.f;
#pragma unroll
        for (int c = 0; c < NCHUNK; ++c) { if (F.bid == 0) MS[bh * NCHUNK + c] = m;
            const float mn = fmaxf(gg[c] + m, am[c]); TB[(bh * NCHUNK + c) * 2] = __expf(gg[c] + m - mn); TB[(bh * NCHUNK + c) * 2 + 1] = __expf(am[c] - mn); m = mn; } }
    __syncthreads();
    const int N = F.G * NTHR, total = NBH * STATE, gt = F.bid * NTHR + tid;
    const int R = total % (2 * N), nfull = total / (2 * N);
    const bool spread = (R > 0 && R <= 8 * F.G && nfull > 0);
    for (int base = 0; base < total; base += 2 * N) {
        if (spread && base + 2 * N > total) break;
        const int i0 = base + gt, i1 = base + N + gt; const bool v0 = i0 < total, v1 = i1 < total;
        if (base + F.bid * NTHR >= total) break;
        const int b0 = v0 ? i0 / STATE : 0, x0 = v0 ? i0 % STATE : 0, b1 = v1 ? i1 / STATE : 0, x1 = v1 ? i1 % STATE : 0;
        const int i2 = total - R + F.bid * 8 + tid; const bool v2 = spread && base == 0 && tid < 8 && i2 < total; const int b2 = v2 ? i2 / STATE : 0, x2 = v2 ? i2 % STATE : 0;
        float d0[NCHUNK], d1[NCHUNK];
#pragma unroll
        for (int c = 0; c < NCHUNK; ++c) { d0[c] = DC[(size_t)(b0 * NCHUNK + c) * STATE + x0]; d1[c] = DC[(size_t)(b1 * NCHUNK + c) * STATE + x1]; }
        if (spread && base == 0 && wave == 0) {
            float d2[NCHUNK];
#pragma unroll
            for (int c = 0; c < NCHUNK; ++c) d2[c] = DC[(size_t)(b2 * NCHUNK + c) * STATE + x2];
            float C2 = 0.f;
#pragma unroll
            for (int c = 0; c < NCHUNK; ++c) { if (v2) CS[(size_t)(b2 * NCHUNK + c) * STATE + x2] = (bf16)f2bf(C2); C2 = TB[(b2 * NCHUNK + c) * 2] * C2 + TB[(b2 * NCHUNK + c) * 2 + 1] * d2[c]; } }
        float C0 = 0.f, C1 = 0.f;
#pragma unroll
        for (int c = 0; c < NCHUNK; ++c) {
            if (v0) CS[(size_t)(b0 * NCHUNK + c) * STATE + x0] = (bf16)f2bf(C0);
            if (v1) CS[(size_t)(b1 * NCHUNK + c) * STATE + x1] = (bf16)f2bf(C1);
            C0 = TB[(b0 * NCHUNK + c) * 2] * C0 + TB[(b0 * NCHUNK + c) * 2 + 1] * d0[c];
            C1 = TB[(b1 * NCHUNK + c) * 2] * C1 + TB[(b1 * NCHUNK + c) * 2 + 1] * d1[c]; } }
    __syncthreads();
}
__device__ __forceinline__ void mix_mlstm_c(const Frame& F, const Args& a, int l, int unit) {
    PHASE_IDS;
    LAS bf16* QI = (LAS bf16*)(F.lds);
    LAS bf16* KI = (LAS bf16*)(F.lds + 17408);
    LAS bf16* VT = (LAS bf16*)(F.lds + 34816);
    LAS bf16* WI = (LAS bf16*)(F.lds + 53248);
    LAS float* HB = (LAS float*)(F.lds + 62464);
    LAS float* al = (LAS float*)(F.lds + 96256); LAS float* mu = al + 64; LAS float* inter = mu + 64; LAS float* flo = inter + 64;
    const int bh = unit / NCHUNK, c = unit % NCHUNK, b = bh >> 2, h = bh & 3, t0 = c * CH, m0 = b * SEQ + t0, hi = lane >> 5;
    const bf16* PROJ = (const bf16*)(F.ws + WS_PROJ); bf16* YCAT = (bf16*)(F.ws + WS_YCAT);
    const bf16* Cs = (const bf16*)(F.ws + WSM_CS) + (size_t)unit * STATE; const float mst = ((const float*)(F.ws + WSM_MS))[unit];
    if (wave == 0) { const float av = ((const float*)(F.ws + WSM_AL))[(size_t)bh * SEQ + t0 + lane]; al[lane] = av; float pm = av;
#pragma unroll
        for (int o = 1; o < 64; o <<= 1) { const float n = __shfl_up(pm, o); if (lane >= o) pm = fmaxf(pm, n); }
        const float m_ = fmaxf(mst, pm); mu[lane] = m_; inter[lane] = __expf(mst - m_); flo[lane] = __expf(-(((const float*)(F.ws + WSM_BB))[(size_t)bh * SEQ + t0 + lane] + m_)); }
    const int tb_ = wave >> 2, eb_ = wave & 3; s16x8 cfr[8], nfr[8]; bf16 op0[8], op1[8];
#pragma unroll
    for (int k = 0; k < 8; ++k) { cfr[k] = ld8g(Cs + (size_t)(eb_ * 32 + (lane & 31)) * 128 + 16 * k + 8 * hi); nfr[k] = ld8g(Cs + 128 * 128 + 16 * k + 8 * hi); }
#pragma unroll
    for (int i = 0; i < 8; ++i) { const size_t m = m0 + wave * 8 + i; op0[i] = PROJ[m * PC + C_O + h * 128 + lane]; op1[i] = PROJ[m * PC + C_O + h * 128 + 64 + lane]; }
    const float* cw = a.in[3] + l * 4 * 1024; const float* cb = a.in[4] + l * 1024;
#pragma unroll
    for (int i = tid; i < 64 * 32; i += NTHR) { const int s = i >> 5, part = i & 31, isk = part >> 4, d8 = (part & 15) * 8; float o[8];
        conv4_silu8(PROJ, m0 + s, t0 + s, isk * 512 + h * 128 + d8, cw, cb, o); const float sc = isk ? 1.f : 0.088388347648318447f;
        v4u w; w.x = pk2(o[0] * sc, o[1] * sc); w.y = pk2(o[2] * sc, o[3] * sc); w.z = pk2(o[4] * sc, o[5] * sc); w.w = pk2(o[6] * sc, o[7] * sc);
        *(LAS v4u*)((isk ? KI : QI) + s * 136 + d8) = w; }
#pragma unroll
    for (int i = tid; i < 64 * 16; i += NTHR) { const int s = i >> 4, d8 = (i & 15) * 8; const v4u vv = *(const v4u*)(PROJ + (size_t)(m0 + s) * PC + C_V + h * 128 + d8);
#pragma unroll
        for (int q = 0; q < 4; ++q) { VT[(d8 + 2 * q) * 72 + swz(d8 + 2 * q, s)] = (bf16)(vv[q] & 0xffffu); VT[(d8 + 2 * q + 1) * 72 + swz(d8 + 2 * q + 1, s)] = (bf16)(vv[q] >> 16); } }
    __syncthreads();
    if (wave < 4) { const int tb = (wave == 0 || wave == 3) ? 0 : 1, sb = (wave >= 2) ? 1 : 0;
        f32x16 S = zero16(); if (wave != 3) mma_ll<128>(S, QI + tb * 32 * 136, 136, KI + sb * 32 * 136, 136, lane);
        const int s = sb * 32 + (lane & 31); const float as = al[s];
#pragma unroll
        for (int r = 0; r < 16; ++r) { const int t = tb * 32 + crow(r, hi); const float w = (wave != 3 && s <= t) ? __expf(as - mu[t]) * S[r] : 0.f; WI[t * 72 + s] = (bf16)f2bf(w); } }
    __syncthreads();
    { const int tb = tb_, eb = eb_; f32x16 acc = zero16(), den = zero16();
        { const int r_ = lane & 31, ko = 8 * hi;
#pragma unroll
            for (int k = 0; k < 8; ++k) { const s16x8 qa = ld8(QI + (tb * 32 + r_) * 136 + 16 * k + ko);
                acc = __builtin_amdgcn_mfma_f32_32x32x16_bf16(qa, cfr[k], acc, 0, 0, 0); den = __builtin_amdgcn_mfma_f32_32x32x16_bf16(qa, nfr[k], den, 0, 0, 0); } }
#pragma unroll
        for (int r = 0; r < 16; ++r) { const float it = inter[tb * 32 + crow(r, hi)]; acc[r] *= it; den[r] *= it; }
        mma_ll_sw<64, false, true>(acc, WI, 72, tb * 32, VT, 72, eb * 32, lane);
        { const int r_ = lane & 31, ko = 8 * hi; s16x8 ones;
#pragma unroll
            for (int j = 0; j < 8; ++j) ones[j] = (short)0x3f80;
#pragma unroll
            for (int k = 0; k < 64; k += 16) den = __builtin_amdgcn_mfma_f32_32x32x16_bf16(ld8(WI + (tb * 32 + r_) * 72 + k + ko), ones, den, 0, 0, 0); }
#pragma unroll
        for (int r = 0; r < 16; ++r) { const int t = tb * 32 + crow(r, hi); HB[t * 132 + eb * 32 + (lane & 31)] = acc[r] * rcpf_(fmaxf(fabsf(den[r]), flo[t])); } }
    __syncthreads();
    { const float* nw = a.in[6] + l * GW + h * 128; const float nw0 = nw[lane], nw1 = nw[64 + lane];
#pragma unroll
        for (int i = 0; i < 8; ++i) { const int t = wave * 8 + i; const float v0 = HB[t * 132 + lane], v1 = HB[t * 132 + 64 + lane];
            const float mean = wave_sum(v0 + v1) * (1.f / 128.f), d0 = v0 - mean, d1 = v1 - mean; const float rs = rsqrtf(wave_sum(d0 * d0 + d1 * d1) * (1.f / 128.f) + EPS);
            const size_t m = m0 + t;
            YCAT[m * D + h * 128 + lane] = (bf16)f2bf(sigmoidf_(bf2f(op0[i])) * d0 * rs * nw0); YCAT[m * D + h * 128 + 64 + lane] = (bf16)f2bf(sigmoidf_(bf2f(op1[i])) * d1 * rs * nw1); } }
    __syncthreads();
}
__device__ __forceinline__ void mix_sb_norm(const Frame& F, const Args& a, int l) {
    PHASE_IDS;
    const bf16* YCR = (const bf16*)(F.ws + WS_NAIVE); bf16* YCAT = (bf16*)(F.ws + WS_YCAT); const float* gw = a.in[15] + l * 3 * GW + GW + lane * 8;
    for (int m = F.bid * NWAVES + wave; m < M; m += F.G * NWAVES) { const v4u rv = *(const v4u*)(YCR + (size_t)m * GW + lane * 8); float v[8];
#pragma unroll
        for (int q = 0; q < 4; ++q) { v[2 * q] = bflo(rv[q]); v[2 * q + 1] = bfhi(rv[q]); }
        float ss = 0.f;
#pragma unroll
        for (int j = 0; j < 8; ++j) ss += v[j] * v[j];
        const float rs = rsqrtf(wave_sum(ss) * (1.f / 512.f) + EPS); const f32x4 g0 = *(const f32x4*)gw, g1 = *(const f32x4*)(gw + 4);
        v4u o; o.x = pk2(v[0] * rs * g0.x, v[1] * rs * g0.y); o.y = pk2(v[2] * rs * g0.z, v[3] * rs * g0.w); o.z = pk2(v[4] * rs * g1.x, v[5] * rs * g1.y); o.w = pk2(v[6] * rs * g1.z, v[7] * rs * g1.w);
        *(v4u*)(YCAT + (size_t)m * D + 1024 + lane * 8) = o; }
}
#ifndef MIXK
#define MIXK 15
#endif
#ifndef PR_CONV
#define PR_CONV 1
#endif
#ifndef PR_POOL
#define PR_POOL 1
#endif
#ifndef PR_SB
#define PR_SB 1
#endif
#ifndef PR_MA
#define PR_MA 1
#endif
#ifndef PR_MC
#define PR_MC 1
#endif
#ifndef PR_SBN
#define PR_SBN 1
#endif
__device__ __forceinline__ void phase_m1(const Frame& F, const Args& a, int l) {
    for (int tile = F.bid; tile < M / 32; tile += F.G) { if (MIXK & 1) for (int rp = 0; rp < PR_CONV; ++rp) mix_conv(F, a, l, tile); if (MIXK & 2) for (int rp = 0; rp < PR_POOL; ++rp) mix_pool(F, a, l, tile); }
    if (MIXK & 4) { PHASE_IDS; for (int rp = 0; rp < PR_SB; ++rp) for (int q = F.bid; q < BATCH * 64; q += F.G) mix_sb_unit(F, a, l, F.lds + wave * 8192, ((q >> 6) * 4 + (wave >> 1)) * 64 + (q & 63), wave & 1, wave, lane); }
    __syncthreads();
    if (MIXK & 8) for (int rp = 0; rp < PR_MA; ++rp) for (int unit = F.bid; unit < NUNIT; unit += F.G) mix_mlstm_a(F, a, l, unit);
}
__device__ __forceinline__ void phase_m3(const Frame& F, const Args& a, int l) {
    if (MIXK & 8) for (int rp = 0; rp < PR_MC; ++rp) for (int unit = F.bid; unit < NUNIT; unit += F.G) mix_mlstm_c(F, a, l, unit);
}
__global__ void k_mlstm_qk(const bf16* __restrict__ proj, const float* __restrict__ cw, const float* __restrict__ cb, float* __restrict__ QM, float* __restrict__ KM) {
    const size_t i = (size_t)blockIdx.x * 256 + threadIdx.x; const int ch = i % 1024, m = i / 1024, t = m % SEQ;
    float acc = cb[ch];
#pragma unroll
    for (int j = 0; j < 4; ++j) { const int tt = t - 3 + j; if (tt >= 0) acc += cw[j * 1024 + ch] * bf2f(proj[(size_t)(m - 3 + j) * PC + C_QK + ch]); }
    const float v = siluf_(acc);
    if (ch < 512) QM[(size_t)m * GW + ch] = v * 0.088388347648318447f; else KM[(size_t)m * GW + ch - 512] = v;
}
__global__ __launch_bounds__(256) void k_mlstm_a(const bf16* __restrict__ proj, const float* __restrict__ GT, const float* __restrict__ KM, const float* __restrict__ gate_b,
                                                 float* __restrict__ DC, float* __restrict__ GA, float* __restrict__ BB, float* __restrict__ AL) {
    extern __shared__ float sm[];
    float* ks = sm; float* vs = sm + 64 * 128; float* sw = vs + 64 * 128;
    const int unit = blockIdx.x, bh = unit / NCHUNK, c = unit % NCHUNK, b = bh / 4, h = bh % 4, m0 = b * SEQ + c * CH, tid = threadIdx.x;
    if (tid < 64) {
        const float ip = GT[(size_t)(m0 + tid) * 8 + h] + gate_b[h];
        const float fp = GT[(size_t)(m0 + tid) * 8 + 4 + h] + gate_b[4 + h];
        float lf = logsigmoidf_(fp);
#pragma unroll
        for (int o = 1; o < 64; o <<= 1) { const float n = __shfl_up(lf, o); if (tid >= o) lf += n; }
        const float g = __shfl(lf, 63);
        const float a = g - lf + ip;
        const float amax = wave_max(a);
        sw[tid] = __expf(a - amax);
        BB[(size_t)(bh * SEQ + c * CH + tid)] = lf;
        AL[(size_t)(bh * SEQ + c * CH + tid)] = ip - lf;
        if (tid == 0) { GA[unit * 2] = g; GA[unit * 2 + 1] = amax; }
    }
    for (int i = tid; i < 64 * 128; i += 256) { const int s = i / 128, d = i % 128;
        ks[i] = KM[(size_t)(m0 + s) * GW + h * 128 + d]; vs[i] = bf2f(proj[(size_t)(m0 + s) * PC + C_V + h * 128 + d]); }
    __syncthreads();
    float* out = DC + (size_t)unit * STATE;
    for (int o = tid; o < 128 * 128; o += 256) { const int e = o / 128, dk = o % 128; float acc = 0.f;
        for (int s = 0; s < 64; ++s) acc += sw[s] * ks[s * 128 + dk] * vs[s * 128 + e];
        out[o] = acc; }
    if (tid < 128) { float acc = 0.f; for (int s = 0; s < 64; ++s) acc += sw[s] * ks[s * 128 + tid]; out[128 * 128 + tid] = acc; }
}
__global__ void k_mlstm_b(const float* __restrict__ DC, const float* __restrict__ GA, float* __restrict__ CS, float* __restrict__ MS) {
    const int i = blockIdx.x * 256 + threadIdx.x; if (i >= NBH * STATE) return;
    const int bh = i / STATE, idx = i % STATE;
    float m = 0.f, C = 0.f;
    for (int c = 0; c < NCHUNK; ++c) { const int unit = bh * NCHUNK + c;
        CS[(size_t)unit * STATE + idx] = C; if (idx == 0) MS[unit] = m;
        const float g = GA[unit * 2], amax = GA[unit * 2 + 1]; const float mn = fmaxf(g + m, amax);
        C = __expf(g + m - mn) * C + __expf(amax - mn) * DC[(size_t)unit * STATE + idx]; m = mn; }
}
__global__ __launch_bounds__(256) void k_mlstm_c(const bf16* __restrict__ proj, const float* __restrict__ QM, const float* __restrict__ KM, const float* __restrict__ CS,
                                                 const float* __restrict__ MS, const float* __restrict__ BB, const float* __restrict__ AL, const float* __restrict__ norm_w, bf16* __restrict__ YCAT) {
    extern __shared__ float sm[];
    float* qs = sm; float* ks = qs + 64 * 129; float* vs = ks + 64 * 129; float* S = vs + 64 * 128; float* al = S + 64 * 65; float* mu = al + 64; float* den = mu + 64; float* hb = den + 64;
    const int unit = blockIdx.x, bh = unit / NCHUNK, c = unit % NCHUNK, b = bh / 4, h = bh % 4, m0 = b * SEQ + c * CH, tid = threadIdx.x;
    const float mst = MS[unit];
    for (int i = tid; i < 64 * 128; i += 256) { const int s = i / 128, d = i % 128;
        qs[s * 129 + d] = QM[(size_t)(m0 + s) * GW + h * 128 + d]; ks[s * 129 + d] = KM[(size_t)(m0 + s) * GW + h * 128 + d]; vs[i] = bf2f(proj[(size_t)(m0 + s) * PC + C_V + h * 128 + d]); }
    if (tid < 64) { float a = AL[(size_t)bh * SEQ + c * CH + tid]; al[tid] = a;
        float pm = a;
#pragma unroll
        for (int o = 1; o < 64; o <<= 1) { const float n = __shfl_up(pm, o); if (tid >= o) pm = fmaxf(pm, n); }
        mu[tid] = fmaxf(mst, pm); }
    __syncthreads();
    for (int o = tid; o < 64 * 64; o += 256) { const int t = o / 64, s = o % 64; float acc = 0.f;
        if (s <= t) { for (int d = 0; d < 128; ++d) acc += qs[t * 129 + d] * ks[s * 129 + d]; acc *= __expf(al[s] - mu[t]); }
        S[t * 65 + s] = acc; }
    __syncthreads();
    const float* Cst = CS + (size_t)unit * STATE;
    if (tid < 64) { const int t = tid; float qn = 0.f; for (int d = 0; d < 128; ++d) qn += qs[t * 129 + d] * Cst[128 * 128 + d];
        float sw = 0.f; for (int s = 0; s <= t; ++s) sw += S[t * 65 + s];
        const float inter = __expf(mst - mu[t]); const float dn = inter * qn + sw;
        const float bt = BB[(size_t)bh * SEQ + c * CH + t];
        den[t] = fmaxf(fabsf(dn), __expf(-(bt + mu[t]))); }
    __syncthreads();
    for (int o = tid; o < 64 * 128; o += 256) { const int t = o / 128, e = o % 128; float acc = 0.f;
        for (int d = 0; d < 128; ++d) acc += qs[t * 129 + d] * Cst[e * 128 + d];
        acc *= __expf(mst - mu[t]);
        for (int s = 0; s <= t; ++s) acc += S[t * 65 + s] * vs[s * 128 + e];
        hb[t * 129 + e] = acc / den[t]; }
    __syncthreads();
    const int wave = tid / 64, lane = tid % 64;
    for (int t = wave * 16; t < wave * 16 + 16; ++t) {
        const float v0 = hb[t * 129 + lane], v1 = hb[t * 129 + 64 + lane];
        const float mean = wave_sum(v0 + v1) * (1.f / 128.f); const float d0 = v0 - mean, d1 = v1 - mean;
        const float var = wave_sum(d0 * d0 + d1 * d1) * (1.f / 128.f); const float rs = rsqrtf(var + EPS);
        const size_t m = m0 + t;
        const float o0 = bf2f(proj[m * PC + C_O + h * 128 + lane]), o1 = bf2f(proj[m * PC + C_O + h * 128 + 64 + lane]);
        YCAT[m * D + h * 128 + lane] = (bf16)f2bf(sigmoidf_(o0) * d0 * rs * norm_w[h * 128 + lane]);
        YCAT[m * D + h * 128 + 64 + lane] = (bf16)f2bf(sigmoidf_(o1) * d1 * rs * norm_w[h * 128 + 64 + lane]); }
}
__global__ void k_pool1(const bf16* __restrict__ proj, float* __restrict__ P) {
    const size_t i = (size_t)blockIdx.x * 256 + threadIdx.x; const int ch = i % GW, m = i / GW, t = m % SEQ, g = ch / 128, win = 2 << g;
    const int n = (t + 1 < win) ? t + 1 : win; float s = 0.f;
    for (int j = 0; j < n; ++j) s += bf2f(proj[(size_t)(m - j) * PC + C_POOL + ch]);
    P[i] = s / (float)n - bf2f(proj[(size_t)m * PC + C_POOL + ch]);
}
__global__ void k_pool2(const float* __restrict__ P, const float* __restrict__ pw, const float* __restrict__ pscale, float* __restrict__ Y) {
    const size_t i = (size_t)blockIdx.x * 256 + threadIdx.x; const int ch = i % GW, m = i / GW, g = ch / 128, e = ch % 128;
    float acc = 0.f; const float* p = P + (size_t)m * GW + g * 128; const float* w = pw + (size_t)g * 128 * 128 + e;
    for (int c = 0; c < 128; ++c) acc += p[c] * w[c * 128];
    Y[i] = acc * pscale[ch];
}
__global__ void k_rms512(const float* __restrict__ Y, const float* __restrict__ gw, bf16* __restrict__ YCAT, int off) {
    const int m = blockIdx.x * 4 + threadIdx.x / 64, lane = threadIdx.x % 64; float v[8]; float ss = 0.f;
#pragma unroll
    for (int j = 0; j < 8; ++j) { v[j] = Y[(size_t)m * GW + lane + 64 * j]; ss += v[j] * v[j]; }
    const float rs = rsqrtf(wave_sum(ss) * (1.f / 512.f) + EPS);
#pragma unroll
    for (int j = 0; j < 8; ++j) YCAT[(size_t)m * D + off + lane + 64 * j] = (bf16)f2bf(v[j] * rs * gw[lane + 64 * j]);
}
__global__ __launch_bounds__(256) void k_sb(const bf16* __restrict__ proj, float* __restrict__ Y) {
    __shared__ float qsh[4][128];
    const int wave = threadIdx.x / 64, lane = threadIdx.x % 64;
    const int row = blockIdx.x * 4 + wave;
    const int m = row / 4, h = row % 4, t = m % SEQ, mb = m - t;
    const bf16* qp = proj + (size_t)m * PC + C_SB + h * 128;
    qsh[wave][lane] = bf2f(qp[lane]); qsh[wave][lane + 64] = bf2f(qp[lane + 64]);
    __syncthreads();
    float o0 = 0.f, o1 = 0.f, P = 1.f;
    for (int shi = t - 1; shi >= 0 && P > 0.f; shi -= 64) {
        const int s = shi - lane; const bool valid = s >= 0;
        float beta = 0.f, keep = 1.f;
        if (valid) { const bf16* kp = proj + (size_t)(mb + s) * PC + C_SB + 512 + h * 128; float z = 0.f;
            for (int d = 0; d < 128; d += 2) { const unsigned kv = *(const unsigned*)(kp + d); z += qsh[wave][d] * __uint_as_float(kv << 16) + qsh[wave][d + 1] * __uint_as_float(kv & 0xffff0000u); }
            z *= 0.088388347648318447f; z = fminf(fmaxf(z, -80.f), 80.f);
            const float e = __expf(-z); beta = 1.f / (1.f + e); keep = e * beta; }
        float inc = keep;
#pragma unroll
        for (int o = 1; o < 64; o <<= 1) { const float n = __shfl_up(inc, o); if (lane >= o) inc *= n; }
        float exc = __shfl_up(inc, 1); if (lane == 0) exc = 1.f;
        const float a = beta * P * exc;
        P *= __shfl(inc, 63);
        const int nk = (shi + 1 < 64) ? shi + 1 : 64;
        for (int l = 0; l < nk; ++l) { const float al = __shfl(a, l); const bf16* vp = proj + (size_t)(mb + shi - l) * PC + C_SB + 1024 + h * 128;
            o0 += al * bf2f(vp[lane]); o1 += al * bf2f(vp[lane + 64]); }
    }
    Y[(size_t)m * GW + h * 128 + lane] = o0; Y[(size_t)m * GW + h * 128 + lane + 64] = o1;
}
__global__ void k_glu(const bf16* __restrict__ proj, float* __restrict__ Hg) {
    const size_t i = (size_t)blockIdx.x * 256 + threadIdx.x; const int ch = i % GW, m = i / GW;
    Hg[i] = bf2f(proj[(size_t)m * PC + C_CONV + ch]) * sigmoidf_(bf2f(proj[(size_t)m * PC + C_CONV + 512 + ch]));
}
__global__ void k_dwconv(const float* __restrict__ Hg, const float* __restrict__ w, const float* __restrict__ bias, float* __restrict__ CV) {
    const size_t i = (size_t)blockIdx.x * 256 + threadIdx.x; const int ch = i % GW, m = i / GW, t = m % SEQ;
    float acc = bias[ch];
    for (int j = 0; j < 31; ++j) { const int tt = t - 30 + j; if (tt >= 0) acc += w[j * GW + ch] * Hg[(size_t)(m - 30 + j) * GW + ch]; }
    CV[i] = acc;
}
__global__ void k_ln512_silu(const float* __restrict__ CV, const float* __restrict__ lw, const float* __restrict__ lb, float* __restrict__ CL) {
    const int m = blockIdx.x * 4 + threadIdx.x / 64, lane = threadIdx.x % 64; float v[8]; float s = 0.f;
#pragma unroll
    for (int j = 0; j < 8; ++j) { v[j] = CV[(size_t)m * GW + lane + 64 * j]; s += v[j]; }
    const float mean = wave_sum(s) * (1.f / 512.f); float q = 0.f;
#pragma unroll
    for (int j = 0; j < 8; ++j) { v[j] -= mean; q += v[j] * v[j]; }
    const float rs = rsqrtf(wave_sum(q) * (1.f / 512.f) + EPS);
#pragma unroll
    for (int j = 0; j < 8; ++j) { const int c = lane + 64 * j; CL[(size_t)m * GW + c] = siluf_(v[j] * rs * lw[c] + lb[c]); }
}
__global__ void k_pw(const float* __restrict__ A, const float* __restrict__ W, const float* __restrict__ bias, float* __restrict__ Y) {
    __shared__ float as[4][GW];
    const int m0 = blockIdx.x * 4, tid = threadIdx.x;
    for (int i = tid; i < 4 * GW; i += 256) as[i / GW][i % GW] = A[(size_t)(m0 + i / GW) * GW + i % GW];
    __syncthreads();
    for (int n = tid; n < GW; n += 256) { float a0 = 0, a1 = 0, a2 = 0, a3 = 0;
        for (int k = 0; k < GW; ++k) { const float w = W[(size_t)k * GW + n]; a0 += as[0][k] * w; a1 += as[1][k] * w; a2 += as[2][k] * w; a3 += as[3][k] * w; }
        const float bv = bias[n]; Y[(size_t)(m0 + 0) * GW + n] = a0 + bv; Y[(size_t)(m0 + 1) * GW + n] = a1 + bv; Y[(size_t)(m0 + 2) * GW + n] = a2 + bv; Y[(size_t)(m0 + 3) * GW + n] = a3 + bv; }
}
constexpr int NPHASE = 22;
#ifndef PR_P0
#define PR_P0 1
#endif
#ifndef PR_ROW
#define PR_ROW 1
#endif
#ifndef PR_GEMM
#define PR_GEMM 1
#endif
#ifndef PR_MIX
#define PR_MIX 1
#endif
#ifndef PR_SCAN
#define PR_SCAN 1
#endif
#ifndef PR_G
#define PR_G(i) PR_GEMM
#endif
__global__ void __launch_bounds__(NTHR, 2) mega(Args a) {
    extern __shared__ __attribute__((aligned(16))) unsigned char lds[];
    Frame F; F.lds = (LAS unsigned char*)lds; F.G = gridDim.x; F.bid = blockIdx.x; F.ws = a.ws; const int tid = threadIdx.x;
    volatile LAS unsigned* MISC = (volatile LAS unsigned*)(F.lds + MISC_OFF);
    for (int u = tid; u < (LDS_BYTES - LDSCTL_OFF) / 4; u += NTHR) ((LAS unsigned*)(F.lds + LDSCTL_OFF))[u] = 0u;
    __syncthreads();
    XcdBarrier bar = xcd_barrier_post((unsigned*)(a.ws + WS_CTL) + CW_BAR + a.li * XCD_BAR_WORDS, MISC + 8);
    const int lo = a.ph_lo, hi = a.ph_hi;
#define IN(k) (lo <= (k) && (k) < hi)
#define SEAM(k) do { if (IN(k) && IN((k) + 1)) xcd_barrier(bar); } while (0)
    unsigned char* ws = a.ws;
    bf16* U = (bf16*)(ws + WS_U); float* X = (float*)(ws + WS_X); bf16* T = (bf16*)(ws + WS_T); bf16* YCAT = (bf16*)(ws + WS_YCAT); bf16* PROJ = (bf16*)(ws + WS_PROJ); bf16* H = (bf16*)(ws + WS_H);
    const float* ADA = (const float*)(ws + WS_ADA); const int* pane = (const int*)(ws + WS_PANE);
    const int ncv1 = F.G == 256 ? NCV_G1 : 0, ncv3 = F.G == 256 ? NCV_G3 : 0;
    if (IN(0)) for (int rp = 0; rp < PR_P0; ++rp) p0_prologue(F, a);
    SEAM(0);
    if (IN(1)) for (int rp = 0; rp < PR_ROW; ++rp) row_init(F, a);
    SEAM(1);
    for (int l = 0; l < 2; ++l) { const int pb = 2 + 10 * l;
        if (IN(pb + 0)) for (int rp = 0; rp < PR_G(0); ++rp) { const int Gg = F.G - ncv1;
            if (F.bid < Gg) { pg8::Gemm g{U, (const bf16*)(ws + WS_WIN) + (size_t)l * PC * D, M, PC, D}; pg8::StaticOrder S; S.init(M, PC, Gg, F.bid);
                pg8::EpiBf16P E{PROJ, PC, 1 << 20}; pg8::gemm_phase<pg8::EpiBf16P, pg8::StaticOrder, PG8_ALIGN, PG8_SP2>(F.lds + RING_OFF, g, S, E);
                if (ncv1 && ((M / 256) * (PC / 256) - 1) / Gg * Gg + F.bid < (M / 256) * (PC / 256) && otid() == 0) xb_add((unsigned*)(F.ws + WS_CTL) + CW_DONE + 64 * l, 1u); }
            else converter(F, a, l == 0 ? Q_FFN : Q_MOE, l == 0 ? Q_MOE : -1, l); }
        SEAM(pb + 0);
        if (IN(pb + 1)) for (int rp = 0; rp < PR_MIX; ++rp) phase_m1(F, a, l);
        SEAM(pb + 1);
        if (IN(pb + 2) && (MIXK & 8)) for (int rp = 0; rp < PR_MIX * PR_SCAN; ++rp) mix_scan(F);
        SEAM(pb + 2);
        if (IN(pb + 3)) { for (int rp = 0; rp < PR_MIX; ++rp) phase_m3(F, a, l); weight_copies(F, a, IR_OUT0 + l * I_OUT, IR_OUT0 + (l + 1) * I_OUT); }
        SEAM(pb + 3);
        if (IN(pb + 4)) for (int rp = 0; rp < PR_G(1); ++rp) { pg8::Gemm g{YCAT, (const bf16*)(ws + WS_WOUT) + (size_t)l * D * D, M, D, D}; pg8::StaticOrder S; S.init(M, D, F.G, F.bid);
            pg8::EpiResid E{T, l == 0 ? a.in[0] : nullptr, X, a.in[21], a.in[22], ADA + (size_t)l * 4 * D6 + 2 * D};     pg8::gemm_phase<pg8::EpiResid, pg8::StaticOrder, PG8_ALIGN, PG8_SP2>(F.lds + RING_OFF, g, S, E); }
        SEAM(pb + 4);
        if (IN(pb + 5)) { for (int rp = 0; rp < PR_ROW; ++rp) row_ln1(F, a, l); if (l == 0) weight_rest(F, a, Q_FFN); }
        SEAM(pb + 5);
        if (IN(pb + 6) && l == 1) { for (int rp = 0; rp < PR_ROW; ++rp) moe_scatter(F); weight_rest(F, a, Q_MOE); }
        if (l == 1) SEAM(pb + 6);
        if (IN(pb + 7)) for (int rp = 0; rp < PR_G(2); ++rp) {
            if (l == 0) { const int Gg = F.G - ncv3;
                if (F.bid < Gg) { pg8::Gemm g{U, (const bf16*)(ws + WS_WGU), M, 2 * DFF, D}; pg8::StaticOrder S; S.init(M, 2 * DFF, Gg, F.bid);
                    pg8::EpiSwiglu E{H, DFF, 1 << 20}; pg8::gemm_phase<pg8::EpiSwiglu, pg8::StaticOrder, PG8_ALIGN, PG8_SP2>(F.lds + RING_OFF, g, S, E);
                    if (ncv3 && ((M / 256) * (2 * DFF / 256) - 1) / Gg * Gg + F.bid < (M / 256) * (2 * DFF / 256) && otid() == 0) xb_add((unsigned*)(F.ws + WS_CTL) + CW_DONE + 64 * 2, 1u); }
                else converter(F, a, Q_WIN1, Q_MOE, 2); }
            else { const int P = pane[MAXPANEL]; pg8::Gemm g{U, (const bf16*)(ws + WS_MWGU), P * 256, 2 * DFE, D}; pg8::MoeGatherOrder S; S.init(P * 256, 2 * DFE, F.G, F.bid); S.panel_e = pane; S.nNl = 2 * DFE / 256;
                LAS int* IDX = (LAS int*)(F.lds + LDSCTL_OFF + 2048); S.idx = IDX;
                { const int* rtok = (const int*)(ws + WS_RTOK); const int ot = otid();
                    for (int i = 0; i < 8; ++i) { pg8::Unit uu; if (!S.next(i, uu)) break; if (ot < 256) IDX[i * 256 + ot] = rtok[uu.pm * 256 + ot]; }
                    __syncthreads(); }
                pg8::EpiSwiglu E{H, DFE, 2 * DFE / 256}; pg8::gemm_phase<pg8::EpiSwiglu, pg8::MoeGatherOrder, PG8_ALIGN, PG8_SP2>(F.lds + RING_OFF, g, S, E); } }
        SEAM(pb + 7);
        if (IN(pb + 8)) for (int rp = 0; rp < PR_G(3); ++rp) {
            if (l == 0) { pg8::Gemm g{H, (const bf16*)(ws + WS_WD), M, D, DFF}; pg8::StaticOrder S; S.init(M, D, F.G, F.bid);
                pg8::EpiResid E{T, nullptr, X, a.in[19] + l * D, a.in[20] + l * D, ADA + (size_t)l * 4 * D6 + 5 * D}; pg8::gemm_phase<pg8::EpiResid, pg8::StaticOrder, PG8_ALIGN, PG8_SP2>(F.lds + RING_OFF, g, S, E); }
            else { const int P = pane[MAXPANEL]; pg8::Gemm g{H, (const bf16*)(ws + WS_MWD), P * 256, D, DFE}; pg8::MoeOrder S; S.init(P * 256, D, F.G, F.bid); S.panel_e = pane; S.nNl = D / 256;
                pg8::EpiBf16P E{PROJ, D, D / 256}; pg8::gemm_phase<pg8::EpiBf16P, pg8::MoeOrder, PG8_ALIGN, PG8_SP2>(F.lds + RING_OFF, g, S, E); } }
        SEAM(pb + 8);
        if (IN(pb + 9)) { for (int rp = 0; rp < PR_ROW; ++rp) row_ln2(F, a, l); if (l == 0) weight_rest(F, a, Q_WIN1); }
        SEAM(pb + 9);
    }
#undef IN
#undef SEAM
}

extern "C" void kernel_launch(void* const* d_in, const int* in_sizes, int n_in, void* d_out, int out_size, void* d_ws, size_t ws_size, hipStream_t stream) {
    static int grid = 0;
    size_t off = WSM_END; auto alloc = [&](size_t bytes) { void* p = (char*)d_ws + off; off += (bytes + 255) & ~(size_t)255; return p; };
    float* QM = (float*)alloc((size_t)M * GW * 4); float* KM = (float*)alloc((size_t)M * GW * 4);
    float* DC = (float*)alloc((size_t)NUNIT * STATE * 4); float* CS = (float*)alloc((size_t)NUNIT * STATE * 4);
    float* GA = (float*)alloc(NUNIT * 2 * 4); float* MS = (float*)alloc(NUNIT * 4); float* BB = (float*)alloc((size_t)NBH * SEQ * 4); float* AL = (float*)alloc((size_t)NBH * SEQ * 4);
    float* TA = (float*)alloc((size_t)M * GW * 4); float* TB = (float*)alloc((size_t)M * GW * 4);
    if (grid == 0) {
        if (n_in != 31 || out_size != M * D || off > ws_size) { fprintf(stderr, "kernel_launch: unexpected problem (n_in %d out %d) or workspace too small: need %zu have %zu\n", n_in, out_size, off, ws_size); grid = -1; return; }
        int dev = 0, cus = 0, per_cu = 0;
        if (hipGetDevice(&dev) != hipSuccess || hipDeviceGetAttribute(&cus, hipDeviceAttributeMultiprocessorCount, dev) != hipSuccess) { grid = -1; return; }
        if (hipFuncSetAttribute((const void*)mega, hipFuncAttributeMaxDynamicSharedMemorySize, LDS_BYTES) != hipSuccess) { fprintf(stderr, "kernel_launch: hipFuncSetAttribute failed\n"); grid = -1; return; }
        (void)hipFuncSetAttribute((const void*)k_mlstm_a, hipFuncAttributeMaxDynamicSharedMemorySize, 70000); (void)hipFuncSetAttribute((const void*)k_mlstm_c, hipFuncAttributeMaxDynamicSharedMemorySize, 160000);
        if (hipOccupancyMaxActiveBlocksPerMultiprocessor(&per_cu, (const void*)mega, NTHR, LDS_BYTES) != hipSuccess || per_cu < 1) fprintf(stderr, "kernel_launch: occupancy query reports %d blocks per CU\n", per_cu);
        (void)hipGetLastError();
        grid = cus;
    }
    if (grid < 0) return;
    (void)hipMemsetAsync((char*)d_ws + WS_CTL, 0, CTL_ZERO_BYTES, stream);
    Args a{};
    for (int i = 0; i < 31; ++i) a.in[i] = (const float*)d_in[i];
    a.out = (float*)d_out; a.ws = (unsigned char*)d_ws;
    const bf16* PROJ = (const bf16*)((char*)d_ws + WS_PROJ); bf16* YCAT = (bf16*)((char*)d_ws + WS_YCAT); const float* GT = (const float*)((char*)d_ws + WS_GATES);
    int li = 0;
    auto seg = [&](int lo, int hi) { a.ph_lo = lo; a.ph_hi = hi; a.li = li++; hipLaunchKernelGGL(mega, dim3(grid), dim3(NTHR), LDS_BYTES, stream, a); };
    auto mixers = [&](int l) {
        if (!(MIXK & 8)) {
        k_mlstm_qk<<<M * 1024 / 256, 256, 0, stream>>>(PROJ, a.in[3] + l * 4 * 1024, a.in[4] + l * 1024, QM, KM);
        k_mlstm_a<<<NUNIT, 256, (64 * 128 * 2 + 128) * 4, stream>>>(PROJ, GT, KM, a.in[5] + l * 8, DC, GA, BB, AL);
        k_mlstm_b<<<(NBH * STATE + 255) / 256, 256, 0, stream>>>(DC, GA, CS, MS);
        k_mlstm_c<<<NUNIT, 256, (64 * 129 * 3 + 64 * 128 + 64 * 65 + 64 * 3) * 4, stream>>>(PROJ, QM, KM, CS, MS, BB, AL, a.in[6] + l * GW, YCAT); }
        if (!(MIXK & 2)) {
        k_pool1<<<M * GW / 256, 256, 0, stream>>>(PROJ, TA);
        k_pool2<<<M * GW / 256, 256, 0, stream>>>(TA, a.in[7] + (size_t)l * 4 * 128 * 128, a.in[8] + l * GW, TB);
        k_rms512<<<M / 4, 256, 0, stream>>>(TB, a.in[15] + l * 3 * GW, YCAT, 512); }
        if (!(MIXK & 4)) {
        k_sb<<<M, 256, 0, stream>>>(PROJ, TA);
        k_rms512<<<M / 4, 256, 0, stream>>>(TA, a.in[15] + l * 3 * GW + GW, YCAT, 1024); }
        if (!(MIXK & 1)) {
        k_glu<<<M * GW / 256, 256, 0, stream>>>(PROJ, TA);
        k_dwconv<<<M * GW / 256, 256, 0, stream>>>(TA, a.in[9] + (size_t)l * 31 * GW, a.in[10] + l * GW, TB);
        k_ln512_silu<<<M / 4, 256, 0, stream>>>(TB, a.in[11] + l * GW, a.in[12] + l * GW, TA);
        k_pw<<<M / 4, 256, 0, stream>>>(TA, a.in[13] + (size_t)l * GW * GW, a.in[14] + l * GW, TB);
        k_rms512<<<M / 4, 256, 0, stream>>>(TB, a.in[15] + l * 3 * GW + 2 * GW, YCAT, 1536); }
    };
    if (MIXK == 15) seg(0, NPHASE); else { seg(0, 3); mixers(0); seg(3, 13); mixers(1); seg(13, NPHASE); }
}
```

```cpp
#include <hip/hip_runtime.h>
#include <cstdio>
#include <cstdint>

constexpr int D = 2048, BATCH = 4, SEQ = 2048, M = BATCH * SEQ, GW = 512, INC = 5128, DFF = 5632, NE = 8, DFE = 2816;
constexpr int D6 = 6 * D;
constexpr float ALPHA = 1.41421356237309515f, EPS = 1e-5f;
constexpr int PC = 5120;
constexpr int C_QK = 0, C_V = 1024, C_O = 1536, C_POOL = 2048, C_SB = 2560, C_CONV = 4096;
constexpr int NCHUNK = 32, CH = 64, NBH = 16, NUNIT = NBH * NCHUNK;
constexpr int STATE = 128 * 128 + 128;
constexpr int MAXPANEL = 72, PAIRROWS = MAXPANEL * 256;
typedef unsigned short bf16;

__device__ __forceinline__ float rcpf_(float v) { return __builtin_amdgcn_rcpf(v); }
__device__ __forceinline__ float sigmoidf_(float v) { return rcpf_(1.f + __expf(-v)); }
__device__ __forceinline__ float siluf_(float v) { return v * rcpf_(1.f + __expf(-v)); }
__device__ __forceinline__ float logsigmoidf_(float v) { return fminf(v, 0.f) - log1pf(__expf(-fabsf(v))); }
template <int CTRL> __device__ __forceinline__ float dpp_mov(float v) { return __builtin_bit_cast(float, __builtin_amdgcn_update_dpp(0, __builtin_bit_cast(int, v), CTRL, 0xF, 0xF, true)); }
__device__ __forceinline__ float rdlane(float v, int l) { return __builtin_bit_cast(float, __builtin_amdgcn_readlane(__builtin_bit_cast(int, v), l)); }
__device__ __forceinline__ float wave_sum(float v) {
    v += dpp_mov<0xB1>(v);
    v += dpp_mov<0x4E>(v);
    v += dpp_mov<0x141>(v);
    v += dpp_mov<0x140>(v);
    return (rdlane(v, 0) + rdlane(v, 16)) + (rdlane(v, 32) + rdlane(v, 48));
}
__device__ __forceinline__ float wave_max(float v) {
    v = fmaxf(v, dpp_mov<0xB1>(v)); v = fmaxf(v, dpp_mov<0x4E>(v)); v = fmaxf(v, dpp_mov<0x141>(v)); v = fmaxf(v, dpp_mov<0x140>(v));
    return fmaxf(fmaxf(rdlane(v, 0), rdlane(v, 16)), fmaxf(rdlane(v, 32), rdlane(v, 48)));
}
__device__ __forceinline__ float bf2f(bf16 h) { return __uint_as_float(((unsigned)h) << 16); }
__device__ __forceinline__ unsigned pk2(float lo, float hi) { unsigned r; asm("v_cvt_pk_bf16_f32 %0, %1, %2" : "=v"(r) : "v"(lo), "v"(hi)); return r; }
__device__ __forceinline__ unsigned f2bf(float f) { return pk2(f, 0.f) & 0xffffu; }
__device__ __forceinline__ float bflo(unsigned u) { return __uint_as_float(u << 16); }
__device__ __forceinline__ float bfhi(unsigned u) { return __uint_as_float(u & 0xffff0000u); }
namespace pg8 {
#define PG8_LAS __attribute__((address_space(3)))
typedef unsigned short bf16_t;
typedef short bf16x8 __attribute__((ext_vector_type(8)));
typedef float f32x4 __attribute__((ext_vector_type(4)));
typedef unsigned u32x4 __attribute__((ext_vector_type(4)));
constexpr int BM = 256, BK = 64, HALF = 128, HTB = HALF * BK * 2  , STAGE_BYTES = 8 * HTB, NXCD = 8, WGM = 8;

__host__ __device__ __forceinline__ int lds_byte(int r, int c) { const int st = (r >> 4) * 2 + (c >> 5), rr = r & 15, cc = c & 31, ob = rr * 64 + cc * 2; return st * 1024 + (ob ^ (((ob >> 9) & 1) << 5)); }
__host__ __device__ __forceinline__ void stage_rc(int b, int& R, int& C) { const int st = b / 1024, sb = b % 1024, swz = sb ^ (((sb >> 9) & 1) << 5); R = (st >> 1) * 16 + swz / 64; C = (st & 1) * 32 + (swz % 64) / 2; }
__host__ __device__ __forceinline__ int perm32(int rho) { const int n = rho >> 4, i = rho & 15; return 8 * (i >> 2) + 4 * n + (i & 3); }

struct Unit { int pm, pn; };
struct Gemm { const bf16_t* A; const bf16_t* Bt; int M, N, K; };

struct StaticOrder {
    static constexpr bool GATHER = false;
    int nM, nN, nwg, G, c;
    __host__ __device__ void init(int M, int N, int G_, int c_) { nM = M / BM; nN = N / BM; nwg = nM * nN; G = G_; c = c_; }
    __host__ __device__ bool next(int i, Unit& u) const {
        const long L = (long)i * G + c; if (L >= nwg) return false;
        int wgid = (int)L; { const int q = nwg / NXCD, r = nwg % NXCD, xcd = wgid % NXCD, off = wgid / NXCD; wgid = (xcd < r ? xcd * (q + 1) : r * (q + 1) + (xcd - r) * q) + off; }
        const int nig = WGM * nN, gid = wgid / nig, fm = gid * WGM, gsz = (nM - fm) < WGM ? (nM - fm) : WGM;
        u.pm = fm + ((wgid % nig) % gsz); u.pn = (wgid % nig) / gsz; return true;
    }
    __device__ __forceinline__ void a_ready(const Unit&) const {}
    __device__ __forceinline__ void done(const Unit&) const {}
};
__device__ __forceinline__ unsigned cvt_pk_bf16(float lo, float hi) { unsigned r; asm volatile("v_cvt_pk_bf16_f32 %0, %1, %2" : "=v"(r) : "v"(lo), "v"(hi)); return r; }
typedef float f32x2 __attribute__((ext_vector_type(2)));
__device__ __forceinline__ f32x2 gelu_pk(f32x2 v) {
    const f32x2 av = __builtin_elementwise_abs(v), d = av * 0.2316418882f + 1.0f;
    f32x2 t; t.x = __builtin_amdgcn_rcpf(d.x); t.y = __builtin_amdgcn_rcpf(d.y);
    f32x2 q = t * 0.5307027145f + (-0.7265760135f); q = q * t + 0.7107068705f; q = q * t + (-0.142248368f); q = q * t + 0.127414796f; q = q * t;
    const f32x2 s = (v * v) * (-0.72134752044f);
    f32x2 e; e.x = __builtin_amdgcn_exp2f(s.x); e.y = __builtin_amdgcn_exp2f(s.y);
    const f32x2 m = v * (q * e), r = v - m;
    f32x2 o; o.x = v.x < 0.f ? m.x : r.x; o.y = v.y < 0.f ? m.y : r.y; return o;
}

template <int ACT  > struct EpiBf16 {
    static constexpr bool PERM = true, AFTER_DRAIN = false; static_assert(ACT == 0 || ACT == 1, "EpiBf16: ACT is 0 (none) or 1 (gelu_pk)");
    bf16_t* O; int ldc; const float* bias; int split_cols; size_t split_stride; float scale0;
    __device__ __forceinline__ void operator()(const f32x4 (&acc)[2][2][4][2], const Unit& u, int wr, int wc, int fr, int fq) const {
        const int row0 = u.pm * BM + wr * 64 + fr; int colt = u.pn * BM; bf16_t* base = O;
        float sc = 1.f; if (split_cols) { const int t = colt / split_cols; base += (size_t)t * split_stride; colt -= t * split_cols; if (t == 0) sc = scale0; }
        const int col0 = colt + wc * 32 + 8 * fq, bcol0 = u.pn * BM + wc * 32 + 8 * fq;
        f32x4 bv[2][2];
#pragma unroll
        for (int bj = 0; bj < 2; ++bj)
#pragma unroll
            for (int n = 0; n < 2; ++n) bv[bj][n] = bias ? *(const f32x4*)(bias + bcol0 + bj * HALF + 4 * n) : (f32x4){0.f, 0.f, 0.f, 0.f};
#pragma unroll
        for (int ai = 0; ai < 2; ++ai)
#pragma unroll
            for (int m = 0; m < 4; ++m) { bf16_t* rowp = base + (size_t)(row0 + ai * HALF + m * 16) * ldc + col0;
#pragma unroll
                for (int bj = 0; bj < 2; ++bj) { f32x4 v0 = acc[ai][bj][m][0] + bv[bj][0], v1 = acc[ai][bj][m][1] + bv[bj][1];
                    if (ACT == 1) { f32x2 a = gelu_pk((f32x2){v0[0], v0[1]}), b = gelu_pk((f32x2){v0[2], v0[3]}), c = gelu_pk((f32x2){v1[0], v1[1]}), d = gelu_pk((f32x2){v1[2], v1[3]});
                        v0 = (f32x4){a.x, a.y, b.x, b.y}; v1 = (f32x4){c.x, c.y, d.x, d.y}; }
                    v0 = v0 * sc; v1 = v1 * sc; u32x4 w; w.x = cvt_pk_bf16(v0[0], v0[1]); w.y = cvt_pk_bf16(v0[2], v0[3]); w.z = cvt_pk_bf16(v1[0], v1[1]); w.w = cvt_pk_bf16(v1[2], v1[3]);
                    *(u32x4*)(rowp + bj * HALF) = w; } }
    }
};
template <class Epi, class Sched, bool ALIGN_EPI = false, bool SP2 = false>
__device__ __forceinline__ void gemm_phase(PG8_LAS unsigned char* lds, const Gemm g, const Sched& S, const Epi& E) {
    int tid_ = threadIdx.x; asm volatile("" : "+v"(tid_));
    const int tid = tid_, wid = __builtin_amdgcn_readfirstlane(tid >> 6), lane = tid & 63, wr = wid >> 2, wc = wid & 3, fr = lane & 15, fq = lane >> 4;
    const int K = g.K, nt = K / BK;
    unsigned voffA[2], voffB[2];
    { int R, C; stage_rc(tid * 16, R, C); const int Rb = Epi::PERM ? ((R & ~31) + perm32(R & 31)) : R;
        voffA[0] = (unsigned)(R * K + C) * 2u; voffB[0] = (unsigned)(Rb * K + C) * 2u;
        voffA[1] = voffA[0] + (unsigned)(64 * K * 2); voffB[1] = voffB[0] + (unsigned)(64 * K * 2); }
    unsigned pkA0 = 0u, pkA1 = 0u;
#define PG8_GOFF(uidx) do { if constexpr (Sched::GATHER) { int _R0, _C0, _R1, _C1; stage_rc(tid * 16, _R0, _C0); stage_rc(tid * 16 + 8192, _R1, _C1); \
        pkA0 = (unsigned)S.idx[(uidx) * 256 + _R0] | ((unsigned)S.idx[(uidx) * 256 + _R1] << 16); pkA1 = (unsigned)S.idx[(uidx) * 256 + HALF + _R0] | ((unsigned)S.idx[(uidx) * 256 + HALF + _R1] << 16); } } while (0)
#define PG8_STAGE_A(bufoff, gbase, h) do { unsigned _o[2]; if constexpr (Sched::GATHER) { int _R, _C; stage_rc(tid * 16, _R, _C); const unsigned _p = (h) ? pkA1 : pkA0; \
        _o[0] = ((_p & 0xffffu) * (unsigned)K + (unsigned)_C) * 2u; _o[1] = ((_p >> 16) * (unsigned)K + (unsigned)_C) * 2u; } else { _o[0] = voffA[0]; _o[1] = voffA[1]; } \
        PG8_STAGE(bufoff, gbase, _o); } while (0)
    const size_t kstep = (size_t)(BK * 2);
    const size_t hstep = (size_t)HALF * K * 2;
    const size_t tstep = 2 * hstep;
    const size_t hstepA = Sched::GATHER ? 0 : hstep, tstepA = Sched::GATHER ? 0 : tstep;
    const unsigned ldsw = (unsigned)wid * 1024u;
    const int aoff = lds_byte(wr * 64 + fr, fq * 8), boff = lds_byte(wc * 32 + fr, fq * 8);
#define PG8_SA(b, h) (((b) * 2 + (h)) * HTB)
#define PG8_SB(b, h) ((4 + (b) * 2 + (h)) * HTB)
#define PG8_STAGE(bufoff, gbase, voff) do { _Pragma("unroll") for (int _i = 0; _i < 2; ++_i) \
        __builtin_amdgcn_global_load_lds((const unsigned*)((const char*)(gbase) + (voff)[_i]), (PG8_LAS unsigned*)(lds + (bufoff) + ldsw + _i * 8192), 16, 0, 0); } while (0)
#define PG8_LDA(dst, b, h) do { _Pragma("unroll") for (int m = 0; m < 4; ++m) _Pragma("unroll") for (int k = 0; k < 2; ++k) dst[m][k] = *(const PG8_LAS bf16x8*)(lds + PG8_SA(b, h) + aoff + m * 2048 + k * 1024); } while (0)
#define PG8_LDB(dst, b, h) do { _Pragma("unroll") for (int n = 0; n < 2; ++n) _Pragma("unroll") for (int k = 0; k < 2; ++k) dst[n][k] = *(const PG8_LAS bf16x8*)(lds + PG8_SB(b, h) + boff + n * 2048 + k * 1024); } while (0)
#define PG8_MMA(ai, bj, At, Bt) do { __builtin_amdgcn_s_setprio(1); _Pragma("unroll") for (int m = 0; m < 4; ++m) _Pragma("unroll") for (int n = 0; n < 2; ++n) _Pragma("unroll") for (int k = 0; k < 2; ++k) \
        acc[ai][bj][m][n] = __builtin_amdgcn_mfma_f32_16x16x32_bf16(Bt[n][k], At[m][k], acc[ai][bj][m][n], 0, 0, 0); __builtin_amdgcn_s_setprio(0); } while (0)
#define PG8_WAIT_V(n) asm volatile("s_waitcnt vmcnt(" #n ")" ::: "memory")
#define PG8_WAIT_L(n) asm volatile("s_waitcnt lgkmcnt(" #n ")" ::: "memory")
#define PG8_BAR __builtin_amdgcn_s_barrier()
#define PG8_SCHED __builtin_amdgcn_sched_barrier(0)
    Unit cur, nxt; int ui = 0;
    if (!S.next(0, cur)) return;
    f32x4 acc[2][2][4][2];
#pragma unroll
    for (int a = 0; a < 2; ++a)
#pragma unroll
        for (int b = 0; b < 2; ++b)
#pragma unroll
            for (int m = 0; m < 4; ++m)
#pragma unroll
                for (int n = 0; n < 2; ++n) acc[a][b][m][n] = (f32x4){0.f, 0.f, 0.f, 0.f};
    bf16x8 At[4][2], B0[2][2], B1[2][2];
    const char* cA = (const char*)g.A + (size_t)cur.pm * tstepA; const char* cB = (const char*)g.Bt + (size_t)cur.pn * tstep;
    PG8_GOFF(0);
    S.a_ready(cur);
    if constexpr (SP2) {
        PG8_STAGE(PG8_SB(0, 0), cB, voffB); PG8_STAGE(PG8_SB(0, 1), cB + hstep, voffB); PG8_STAGE_A(PG8_SA(0, 0), cA, 0); PG8_STAGE_A(PG8_SA(0, 1), cA + hstepA, 1);
        if (wr == 1) PG8_BAR;
        PG8_WAIT_V(2); PG8_BAR;
        PG8_STAGE(PG8_SB(1, 0), cB + kstep, voffB); PG8_STAGE_A(PG8_SA(1, 0), cA + kstep, 0); PG8_STAGE(PG8_SB(1, 1), cB + hstep + kstep, voffB);
        PG8_WAIT_V(6); PG8_BAR;
    } else {
        PG8_STAGE(PG8_SB(0, 0), cB, voffB); PG8_STAGE_A(PG8_SA(0, 0), cA, 0); PG8_STAGE(PG8_SB(0, 1), cB + hstep, voffB); PG8_STAGE_A(PG8_SA(0, 1), cA + hstepA, 1);
        if (wr == 1) PG8_BAR;
        PG8_WAIT_V(4); PG8_BAR;
        PG8_STAGE(PG8_SB(1, 0), cB + kstep, voffB); PG8_STAGE_A(PG8_SA(1, 0), cA + kstep, 0); PG8_STAGE(PG8_SB(1, 1), cB + hstep + kstep, voffB);
        PG8_WAIT_V(6); PG8_BAR;
    }
    for (;;) {
        const bool has_next = S.next(ui + 1, nxt);
        const char* nA = has_next ? (const char*)g.A + (size_t)nxt.pm * tstepA : cA; const char* nB = has_next ? (const char*)g.Bt + (size_t)nxt.pn * tstep : cB;
        for (int t = 0; t < nt; t += 2) {
            const bool last = (t == nt - 2);

            const char* a1 = cA + (size_t)(t + 1) * kstep;
            const char* a2 = last ? nA : cA + (size_t)(t + 2) * kstep; const char* b2 = last ? nB : cB + (size_t)(t + 2) * kstep;
            const char* a3 = a2 + kstep; const char* b3 = b2 + kstep;
            if (last && has_next) S.a_ready(nxt);
            if constexpr (SP2) {
            PG8_LDB(B0, 0, 0); PG8_LDB(B1, 0, 1); PG8_SCHED; PG8_LDA(At, 0, 0); PG8_STAGE_A(PG8_SA(1, 1), a1 + hstepA, 1); if (last) PG8_GOFF(has_next ? ui + 1 : ui);
            PG8_WAIT_V(8); PG8_WAIT_L(0); PG8_BAR; PG8_MMA(0, 0, At, B0); PG8_MMA(0, 1, At, B1); PG8_BAR; PG8_SCHED;
            PG8_LDA(At, 0, 1); PG8_STAGE(PG8_SB(0, 0), b2, voffB); PG8_STAGE(PG8_SB(0, 1), b2 + hstep, voffB); PG8_STAGE_A(PG8_SA(0, 0), a2, 0);
            PG8_WAIT_V(8); PG8_WAIT_L(0); PG8_BAR; PG8_MMA(1, 0, At, B0); PG8_MMA(1, 1, At, B1); PG8_BAR; PG8_SCHED;
            PG8_LDB(B0, 1, 0); PG8_LDB(B1, 1, 1); PG8_SCHED; PG8_LDA(At, 1, 0); PG8_STAGE_A(PG8_SA(0, 1), a2 + hstepA, 1);
            PG8_WAIT_V(8); PG8_WAIT_L(0); PG8_BAR; PG8_MMA(0, 0, At, B0); PG8_MMA(0, 1, At, B1); PG8_BAR; PG8_SCHED;
            PG8_LDA(At, 1, 1); PG8_STAGE(PG8_SB(1, 0), b3, voffB); PG8_STAGE(PG8_SB(1, 1), b3 + hstep, voffB); PG8_STAGE_A(PG8_SA(1, 0), a3, 0);
            PG8_WAIT_V(8); PG8_WAIT_L(0); PG8_BAR; PG8_MMA(1, 0, At, B0); PG8_MMA(1, 1, At, B1); PG8_BAR; PG8_SCHED;
            } else {
            PG8_LDB(B0, 0, 0); PG8_SCHED; PG8_LDA(At, 0, 0); PG8_STAGE_A(PG8_SA(1, 1), a1 + hstepA, 1); if (last) PG8_GOFF(has_next ? ui + 1 : ui);
            PG8_WAIT_L(8); PG8_BAR; PG8_WAIT_L(0); PG8_MMA(0, 0, At, B0); PG8_BAR; PG8_SCHED;
            PG8_LDB(B1, 0, 1); PG8_STAGE(PG8_SB(0, 0), b2, voffB);
            PG8_BAR; PG8_WAIT_L(0); PG8_MMA(0, 1, At, B1); PG8_BAR;
            PG8_LDA(At, 0, 1); PG8_STAGE_A(PG8_SA(0, 0), a2, 0);
            PG8_BAR; PG8_WAIT_L(0); PG8_MMA(1, 0, At, B0); PG8_BAR; PG8_SCHED;
            PG8_STAGE(PG8_SB(0, 1), b2 + hstep, voffB);
            PG8_WAIT_V(6); PG8_BAR; PG8_MMA(1, 1, At, B1); PG8_BAR;
            PG8_LDB(B0, 1, 0); PG8_SCHED; PG8_LDA(At, 1, 0); PG8_STAGE_A(PG8_SA(0, 1), a2 + hstepA, 1);
            PG8_WAIT_L(8); PG8_BAR; PG8_WAIT_L(0); PG8_MMA(0, 0, At, B0); PG8_BAR; PG8_SCHED;
            PG8_LDB(B1, 1, 1); PG8_STAGE(PG8_SB(1, 0), b3, voffB);
            PG8_BAR; PG8_WAIT_L(0); PG8_MMA(0, 1, At, B1); PG8_BAR;
            PG8_LDA(At, 1, 1); PG8_STAGE_A(PG8_SA(1, 0), a3, 0);
            PG8_BAR; PG8_WAIT_L(0); PG8_MMA(1, 0, At, B0); PG8_BAR; PG8_SCHED;
            PG8_STAGE(PG8_SB(1, 1), b3 + hstep, voffB);
            PG8_WAIT_V(6); PG8_BAR; PG8_MMA(1, 1, At, B1); PG8_BAR;
            }
        }
        if constexpr (ALIGN_EPI) { if (wr == 0) PG8_BAR; }
        if constexpr (!Epi::AFTER_DRAIN) { E(acc, cur, wr, wc, fr, fq); S.done(cur); }
        if (!has_next) break;
#pragma unroll
        for (int a = 0; a < 2; ++a)
#pragma unroll
            for (int b = 0; b < 2; ++b)
#pragma unroll
                for (int m = 0; m < 4; ++m)
#pragma unroll
                    for (int n = 0; n < 2; ++n) acc[a][b][m][n] = (f32x4){0.f, 0.f, 0.f, 0.f};
        cur = nxt; cA = nA; cB = nB; ++ui;
        if constexpr (ALIGN_EPI) { if (wr == 1) PG8_BAR; }
    }
    PG8_WAIT_V(0);
    if constexpr (!ALIGN_EPI) { if (wr == 0) PG8_BAR; }
    PG8_BAR;
    if constexpr (Epi::AFTER_DRAIN) { E.fused(acc, cur, wr, wc, fr, fq, lds, wid, lane); S.done(cur); }
#undef PG8_SA
#undef PG8_SB
#undef PG8_STAGE
#undef PG8_LDA
#undef PG8_LDB
#undef PG8_MMA
#undef PG8_WAIT_V
#undef PG8_WAIT_L
#undef PG8_BAR
#undef PG8_SCHED
#undef PG8_GOFF
#undef PG8_STAGE_A
}
}
namespace pg8 {
struct EpiResid {
    static constexpr bool PERM = false, AFTER_DRAIN = false;
    bf16_t* T; const float* Xin; const float* stats; const float* lw; const float* lb; const float* g;
    __device__ __forceinline__ void operator()(const f32x4 (&acc)[2][2][4][2], const Unit& u, int wr, int wc, int fr, int fq) const {
        typedef unsigned u32x2 __attribute__((ext_vector_type(2))); typedef float f32x2v __attribute__((ext_vector_type(2)));
        const int row0 = u.pm * BM + wr * 64 + fr, col0 = u.pn * BM + wc * 32 + 4 * fq; const int b = (u.pm * BM) / SEQ;
        const bool fromx = (Xin != nullptr);
#pragma unroll
        for (int bj = 0; bj < 2; ++bj)
#pragma unroll
            for (int n = 0; n < 2; ++n) { const int c = col0 + bj * HALF + n * 16;
                const f32x4 gv = *(const f32x4*)(g + (size_t)b * D6 + c) + 1.0f;
                f32x4 wv = (f32x4){0.f, 0.f, 0.f, 0.f}, bv = wv; if (!fromx) { wv = *(const f32x4*)(lw + c); bv = *(const f32x4*)(lb + c); }
#pragma unroll
                for (int ai = 0; ai < 2; ++ai)
#pragma unroll
                    for (int m = 0; m < 4; ++m) { const int r = row0 + ai * HALF + m * 16; const size_t off = (size_t)r * D + c; f32x4 xv;
                        if (fromx) xv = *(const f32x4*)(Xin + off);
                        else { const u32x2 tw = *(const u32x2*)(T + off); const f32x2v st = *(const f32x2v*)(stats + 2 * (size_t)r);
                            xv = (f32x4){__uint_as_float(tw.x << 16), __uint_as_float(tw.x & 0xffff0000u), __uint_as_float(tw.y << 16), __uint_as_float(tw.y & 0xffff0000u)};
                            xv = (xv - st.x) * st.y * wv + bv; }
                        const f32x4 tv = xv * ALPHA + gv * acc[ai][bj][m][n];
                        u32x2 w; w.x = cvt_pk_bf16(tv[0], tv[1]); w.y = cvt_pk_bf16(tv[2], tv[3]); *(u32x2*)(T + off) = w;
                        if (m & 1) asm volatile("" ::: "memory"); } }
    }
};
struct EpiBf16P {
    static constexpr bool PERM = true, AFTER_DRAIN = false;
    bf16_t* O; int ldc; int nN;
    __device__ __forceinline__ void operator()(const f32x4 (&acc)[2][2][4][2], const Unit& u, int wr, int wc, int fr, int fq) const {
        const int row0 = u.pm * BM + wr * 64 + fr, col0 = (u.pn % nN) * BM + wc * 32 + 8 * fq;
#pragma unroll
        for (int ai = 0; ai < 2; ++ai)
#pragma unroll
            for (int m = 0; m < 4; ++m) { bf16_t* rowp = O + (size_t)(row0 + ai * HALF + m * 16) * ldc + col0;
#pragma unroll
                for (int bj = 0; bj < 2; ++bj) { const f32x4 v0 = acc[ai][bj][m][0], v1 = acc[ai][bj][m][1];
                    u32x4 w; w.x = cvt_pk_bf16(v0[0], v0[1]); w.y = cvt_pk_bf16(v0[2], v0[3]); w.z = cvt_pk_bf16(v1[0], v1[1]); w.w = cvt_pk_bf16(v1[2], v1[3]);
                    *(u32x4*)(rowp + bj * HALF) = w; } }
    }
};
__device__ __forceinline__ float silu_fast(float v) { return v * __builtin_amdgcn_rcpf(1.0f + __builtin_amdgcn_exp2f(-1.44269504089f * v)); }
struct EpiSwiglu {
    static constexpr bool PERM = true, AFTER_DRAIN = false;
    bf16_t* H; int ldc; int nN;
    __device__ __forceinline__ void operator()(const f32x4 (&acc)[2][2][4][2], const Unit& u, int wr, int wc, int fr, int fq) const {
        const int row0 = u.pm * BM + wr * 64 + fr, col0 = (u.pn % nN) * HALF + wc * 32 + 8 * fq;
#pragma unroll
        for (int ai = 0; ai < 2; ++ai)
#pragma unroll
            for (int m = 0; m < 4; ++m) { bf16_t* rowp = H + (size_t)(row0 + ai * HALF + m * 16) * ldc + col0;
                const f32x4 g0 = acc[ai][0][m][0], g1 = acc[ai][0][m][1], u0 = acc[ai][1][m][0], u1 = acc[ai][1][m][1];
                float h[8];
#pragma unroll
                for (int j = 0; j < 4; ++j) { h[j] = silu_fast(g0[j]) * u0[j]; h[4 + j] = silu_fast(g1[j]) * u1[j]; }
                u32x4 w; w.x = cvt_pk_bf16(h[0], h[1]); w.y = cvt_pk_bf16(h[2], h[3]); w.z = cvt_pk_bf16(h[4], h[5]); w.w = cvt_pk_bf16(h[6], h[7]);
                *(u32x4*)rowp = w; }
    }
};
struct MoeOrder : StaticOrder {
    const int* panel_e; int nNl;
    __device__ __forceinline__ bool next(int i, Unit& u) const { if (!StaticOrder::next(i, u)) return false; u.pn += panel_e[u.pm] * nNl; return true; }
};
struct MoeGatherOrder : MoeOrder { static constexpr bool GATHER = true; const PG8_LAS int* idx; };
}
#ifndef PG8_SP2
#define PG8_SP2 true
#endif
#ifndef PG8_ALIGN
#define PG8_ALIGN true
#endif
constexpr size_t al256(size_t x) { return (x + 255) & ~(size_t)255; }
constexpr size_t WS_CTL = 0, CTL_ZERO_BYTES = 1u << 20;
constexpr size_t WS_ADA = CTL_ZERO_BYTES;
constexpr size_t WS_PART = WS_ADA + al256((size_t)2 * 4 * D6 * 4);
constexpr size_t WS_GATES = WS_PART + al256((size_t)2 * 16 * 4 * D6 * 4);
constexpr size_t WS_TOKE = WS_GATES + al256((size_t)M * 8 * 4);
constexpr size_t WS_TOKW = WS_TOKE + al256((size_t)M * 2 * 4);
constexpr size_t WS_CNT = WS_TOKW + al256((size_t)M * 2 * 4);
constexpr size_t WS_PPOS = WS_CNT + al256(256 * 8 * 4);
constexpr size_t WS_PANE = WS_PPOS + al256((size_t)M * 2 * 4);
constexpr size_t WS_RTOK = WS_PANE + al256(512);
constexpr size_t WS_WIN = WS_RTOK + al256((size_t)PAIRROWS * 4);
constexpr size_t WS_WOUT = WS_WIN + (size_t)2 * PC * D * 2;
constexpr size_t WS_WGU = WS_WOUT + (size_t)2 * D * D * 2;
constexpr size_t WS_WD = WS_WGU + (size_t)2 * DFF * D * 2;
constexpr size_t WS_MWGU = WS_WD + (size_t)D * DFF * 2;
constexpr size_t WS_MWD = WS_MWGU + (size_t)NE * 2 * DFE * D * 2;
constexpr size_t WS_PWT = WS_MWD + (size_t)NE * D * DFE * 2;
constexpr size_t WS_PLT = WS_PWT + (size_t)2 * GW * GW * 2;
constexpr size_t WS_U = WS_PLT + (size_t)2 * 4 * 128 * 128 * 2;
constexpr size_t WS_X = WS_U + (size_t)M * D * 2;
constexpr size_t WS_T = WS_X + (size_t)M * D * 4;
constexpr size_t WS_YCAT = WS_T + (size_t)M * D * 4;
constexpr size_t WS_PROJ = WS_YCAT + (size_t)M * D * 2;
constexpr size_t WS_H = WS_PROJ + (size_t)M * PC * 2;
constexpr size_t WS_NAIVE = WS_H + (size_t)PAIRROWS * DFE * 2;
static_assert((size_t)PAIRROWS * D * 2 <= (size_t)M * PC * 2 && (size_t)M * DFF <= (size_t)PAIRROWS * DFE, "overlays");
constexpr int CW_TMO = 0, CW_CODE = 1, CW_BAR = 4096;
constexpr int RING_OFF = 0, RING_BYTES = 131072, LDSCTL_OFF = RING_BYTES, MISC_OFF = LDSCTL_OFF + 320, LDS_BYTES = 147456;
constexpr int NWAVES = 8, NTHR = 512;

#define GAS __attribute__((address_space(1)))
#define LAS __attribute__((address_space(3)))
typedef unsigned v4u __attribute__((ext_vector_type(4)));
typedef unsigned v2u __attribute__((ext_vector_type(2)));
typedef float f32x4 __attribute__((ext_vector_type(4)));
#define LDS_WAIT() asm volatile("s_waitcnt lgkmcnt(0)" ::: "memory")
#define XB_TMO      128
#define XB_XCNT(j)  (256  + 64 * (j))
#define XB_XSUB(j)  (1280 + 64 * (j))
#define XB_XGEN(j)  (2304 + 64 * (j))
#define XB_TOP      3328
#define XB_TOPGEN   3392
#define XCD_BAR_WORDS 3456
#define XB_SPIN_CAP (1u << 18)

__device__ __forceinline__ unsigned xb_ld(unsigned* p)              { return __hip_atomic_load(p, __ATOMIC_RELAXED, __HIP_MEMORY_SCOPE_AGENT); }
__device__ __forceinline__ unsigned xb_add(unsigned* p, unsigned v) { return __hip_atomic_fetch_add(p, v, __ATOMIC_RELAXED, __HIP_MEMORY_SCOPE_AGENT); }
__device__ __forceinline__ unsigned xb_xcc_id() { return (unsigned)__builtin_amdgcn_s_getreg((3 << 11) | 20) & 0xFu; }
#define XB_SPIN(cond, bar) do { unsigned _sp = 0; while (cond) { __builtin_amdgcn_s_sleep(1); \
    if ((++_sp & 255u) == 0u) { if (xb_ld(&(bar)[XB_TMO])) break; if (_sp > XB_SPIN_CAP) { atomicAdd(&(bar)[XB_TMO], 1u); break; } } } } while (0)

struct XcdBarrier {
    unsigned* bar; unsigned x;
    volatile LAS unsigned* st;
};

__device__ __forceinline__ XcdBarrier xcd_barrier_post(unsigned* bar, volatile LAS unsigned* st) {
    XcdBarrier b; b.bar = bar; b.x = xb_xcc_id(); b.st = st;
    if (threadIdx.x == 0) (void)xb_add(&bar[XB_XCNT(b.x)], 1u);
    return b;
}
__device__ __forceinline__ void xcd_barrier_complete(unsigned* bar, unsigned x, unsigned& nloc, unsigned& nx) {
    const unsigned G = gridDim.x * gridDim.y * gridDim.z;
    unsigned sum, cnt, mine, sp = 0u;
    for (;;) {
        sum = 0u; cnt = 0u; mine = 0u;
#pragma unroll
        for (unsigned j = 0; j < 16; ++j) { const unsigned c = xb_ld(&bar[XB_XCNT(j)]); sum += c; cnt += (c > 0u) ? 1u : 0u; mine = (j == x) ? c : mine; }
        if (sum == G) break;
        __builtin_amdgcn_s_sleep(1);
        if ((++sp & 255u) == 0u) { if (xb_ld(&bar[XB_TMO])) break; if (sp > XB_SPIN_CAP) { atomicAdd(&bar[XB_TMO], 1u); break; } }
    }
    nloc = mine > 0u ? mine : 1u; nx = cnt > 0u ? cnt : 1u;
}

__device__ __forceinline__ void xcd_barrier(const XcdBarrier& b) {
    asm volatile("s_waitcnt vmcnt(0)" ::: "memory");
    __syncthreads();
    if (threadIdx.x == 0) {
        unsigned* bar = b.bar;
        __builtin_amdgcn_s_waitcnt(0);
        unsigned nloc = b.st[0], nx = b.st[1];
        if (nloc == 0u) { xcd_barrier_complete(bar, b.x, nloc, nx); b.st[0] = nloc; b.st[1] = nx; }
        const unsigned old = xb_add(&bar[XB_XSUB(b.x)], 1u);
        const unsigned gen = old / nloc;
        if (old + 1u == (gen + 1u) * nloc) {
            __builtin_amdgcn_fence(__ATOMIC_RELEASE, "agent");
            asm volatile("s_waitcnt vmcnt(0)" ::: "memory");
            const unsigned og = xb_add(&bar[XB_TOP], 1u);
            const unsigned tg = og / nx;
            if (og + 1u == (tg + 1u) * nx) xb_add(&bar[XB_TOPGEN], 1u);
            else XB_SPIN(xb_ld(&bar[XB_TOPGEN]) == tg, bar);
            __builtin_amdgcn_fence(__ATOMIC_ACQUIRE, "agent");
            xb_add(&bar[XB_XGEN(b.x)], 1u);
            asm volatile("s_waitcnt vmcnt(0)" ::: "memory");
        } else {
            XB_SPIN(xb_ld(&bar[XB_XGEN(b.x)]) == gen, bar);
            __builtin_amdgcn_fence(__ATOMIC_ACQUIRE, "agent");
            asm volatile("s_waitcnt vmcnt(0)" ::: "memory");
        }
    }
    __syncthreads();
}
struct Args { const float* in[31]; float* out; unsigned char* ws; int ph_lo, ph_hi, li, pad; };
struct Frame { LAS unsigned char* lds; int G, bid; unsigned char* ws; };
__device__ __forceinline__ int otid() { int t = threadIdx.x; asm volatile("" : "+v"(t)); return t; }
#define PHASE_IDS const int tid = otid(), lane = tid & 63, wave = __builtin_amdgcn_readfirstlane(tid >> 6); (void)lane; (void)wave

struct CItem { const float* src; bf16* dst; int ld, K; };
__device__ __forceinline__ void conv_load(const CItem& c, float (&tv)[64], int lane) {
#pragma unroll
    for (int i = 0; i < 64; ++i) tv[i] = __builtin_nontemporal_load(c.src + (size_t)i * c.ld + lane);
}
template <bool NT = false> __device__ __forceinline__ void conv_store(const CItem& c, const float (&tv)[64], LAS bf16* scr, int lane) {
#pragma unroll
    for (int i = 0; i < 64; i += 2) *(LAS unsigned*)(scr + lane * 66 + i) = pk2(tv[i], tv[i + 1]);
    LDS_WAIT(); asm volatile("" ::: "memory");
#pragma unroll
    for (int q = 0; q < 8; ++q) { const int pce = lane + 64 * q, n = pce >> 3, cc = pce & 7; const LAS unsigned* s = (const LAS unsigned*)(scr + n * 66 + cc * 8);
        v4u o; o.x = s[0]; o.y = s[1]; o.z = s[2]; o.w = s[3];
        if (NT) __builtin_nontemporal_store(o, (v4u*)(c.dst + (size_t)n * c.K + 8 * cc)); else *(v4u*)(c.dst + (size_t)n * c.K + 8 * cc) = o; }
    LDS_WAIT(); asm volatile("" ::: "memory");
}
constexpr int I_IN = (PC / 64) * (D / 64), I_OUT = (D / 64) * (D / 64), I_GU = (2 * DFF / 64) * (D / 64), I_D = (D / 64) * (DFF / 64);
constexpr int I_MGU = (2 * DFE / 64) * (D / 64), I_MD = (D / 64) * (DFE / 64), I_PW = (GW / 64) * (GW / 64), I_PL = (128 / 64) * (128 / 64);
constexpr int NITEMS = 2 * I_IN + 2 * I_OUT + I_GU + I_D + NE * I_MGU + NE * I_MD + 2 * I_PW + 8 * I_PL;
__device__ __forceinline__ CItem conv_decode(const Frame& F, const Args& a, int it) {
    CItem c;
        int r = it;
        if (r < 2 * I_IN) { const int l = r / I_IN; r %= I_IN; const int rb = r % (PC / 64), kb = r / (PC / 64); const int n0 = rb * 64 + (rb * 64 >= 2048 ? 8 : 0);
            c.src = (a.in[2] + (size_t)l * D * INC) + (size_t)(kb * 64) * (INC) + (n0); c.ld = INC; c.dst = ((bf16*)(F.ws + WS_WIN) + ((size_t)l * PC + rb * 64) * D) + (kb * 64); c.K = D; return c; } r -= 2 * I_IN;
        if (r < 2 * I_OUT) { const int l = r / I_OUT; r %= I_OUT; const int rb = r % (D / 64), kb = r / (D / 64);
            c.src = (a.in[16] + (size_t)l * D * D) + (size_t)(kb * 64) * (D) + (rb * 64); c.ld = D; c.dst = ((bf16*)(F.ws + WS_WOUT) + ((size_t)l * D + rb * 64) * D) + (kb * 64); c.K = D; return c; } r -= 2 * I_OUT;
        if (r < I_GU) { const int rb = r % (2 * DFF / 64), kb = r / (2 * DFF / 64), row = rb * 64, j = row / 256, w = row % 256;
            c.src = (w < 128 ? a.in[23] : a.in[24]) + (size_t)(kb * 64) * (DFF) + (128 * j + (w & 127)); c.ld = DFF; c.dst = ((bf16*)(F.ws + WS_WGU) + (size_t)row * D) + (kb * 64); c.K = D; return c; } r -= I_GU;
        if (r < I_D) { const int rb = r % (D / 64), kb = r / (D / 64);
            c.src = (a.in[25]) + (size_t)(kb * 64) * (D) + (rb * 64); c.ld = D; c.dst = ((bf16*)(F.ws + WS_WD) + (size_t)(rb * 64) * DFF) + (kb * 64); c.K = DFF; return c; } r -= I_D;
        if (r < NE * I_MGU) { const int e = r / I_MGU; r %= I_MGU; const int rb = r % (2 * DFE / 64), kb = r / (2 * DFE / 64), row = rb * 64, j = row / 256, w = row % 256;
            c.src = ((w < 128 ? a.in[28] : a.in[29]) + (size_t)e * D * DFE) + (size_t)(kb * 64) * (DFE) + (128 * j + (w & 127)); c.ld = DFE; c.dst = ((bf16*)(F.ws + WS_MWGU) + ((size_t)e * 2 * DFE + row) * D) + (kb * 64); c.K = D; return c; } r -= NE * I_MGU;
        if (r < NE * I_MD) { const int e = r / I_MD; r %= I_MD; const int rb = r % (D / 64), kb = r / (D / 64);
            c.src = (a.in[30] + (size_t)e * DFE * D) + (size_t)(kb * 64) * (D) + (rb * 64); c.ld = D; c.dst = ((bf16*)(F.ws + WS_MWD) + ((size_t)e * D + rb * 64) * DFE) + (kb * 64); c.K = DFE; return c; } r -= NE * I_MD;
        if (r < 2 * I_PW) { const int l = r / I_PW; r %= I_PW; const int rb = r % (GW / 64), kb = r / (GW / 64);
            c.src = (a.in[13] + (size_t)l * GW * GW) + (size_t)(kb * 64) * (GW) + (rb * 64); c.ld = GW; c.dst = ((bf16*)(F.ws + WS_PWT) + ((size_t)l * GW + rb * 64) * GW) + (kb * 64); c.K = GW; return c; } r -= 2 * I_PW;
        { const int lg = r / I_PL; r %= I_PL; const int rb = r % 2, kb = r / 2;
            c.src = (a.in[7] + (size_t)lg * 128 * 128) + (size_t)(kb * 64) * (128) + (rb * 64); c.ld = 128; c.dst = ((bf16*)(F.ws + WS_PLT) + ((size_t)lg * 128 + rb * 64) * 128) + (kb * 64); c.K = 128; }
        return c;
}
constexpr int I_M0 = 2 * I_IN + 2 * I_OUT + I_GU + I_D, I_M1 = I_M0 + NE * I_MGU + NE * I_MD;
__device__ __forceinline__ void conv_items(const Frame& F, const Args& a, int lo, int hi, int skip0, int skip1, int gw, int NGW, LAS bf16* scr, int lane) {
    const int n = (hi - lo) - (skip1 - skip0);
    for (int it = gw; it < n; it += 2 * NGW) {
        const bool v1 = it + NGW < n; int i0 = hi - 1 - it, i1 = hi - 1 - (v1 ? it + NGW : it);
        if (i0 < skip1) i0 -= (skip1 - skip0); if (i1 < skip1) i1 -= (skip1 - skip0);
        const CItem c0 = conv_decode(F, a, i0), c1 = conv_decode(F, a, i1);
        float t0[64], t1[64];
        conv_load(c0, t0, lane); if (v1) conv_load(c1, t1, lane);
        conv_store(c0, t0, scr, lane); if (v1) conv_store(c1, t1, scr, lane); }
}
constexpr int IR_IN0 = 0, IR_IN1 = I_IN, IR_OUT0 = 2 * I_IN, IR_OUT1 = 2 * I_IN + I_OUT, IR_GU = 2 * I_IN + 2 * I_OUT, IR_MIX = I_M1;
__device__ __forceinline__ void weight_copies(const Frame& F, const Args& a, int lo, int hi) {
    PHASE_IDS;
    __syncthreads();
    LAS bf16* scr = (LAS bf16*)(F.lds + RING_OFF + 8192 + wave * 8704);
    conv_items(F, a, lo, hi, hi, hi, F.bid * NWAVES + wave, F.G * NWAVES, scr, lane);
}
constexpr int CW_Q = 1024  , CW_DONE = 1280  ;
constexpr int Q_FFN = 0, Q_MOE = 1, Q_WIN1 = 2;
__device__ __forceinline__ int q_lo(int q) { return q == Q_FFN ? IR_GU : q == Q_MOE ? I_M0 : IR_IN1; }
__device__ __forceinline__ int q_hi(int q) { return q == Q_FFN ? I_M0 : q == Q_MOE ? I_M1 : 2 * I_IN; }
__device__ __forceinline__ void converter(const Frame& F, const Args& a, int qa, int qb, int cp) {
#ifdef CV_IDLE
    return;
#endif
    PHASE_IDS;
    unsigned* ctl = (unsigned*)(F.ws + WS_CTL); unsigned* done = ctl + CW_DONE + 64 * cp;
    LAS bf16* scr = (LAS bf16*)(F.lds + RING_OFF + 8192 + wave * 8704);
    volatile LAS int* CL = (volatile LAS int*)(F.lds + RING_OFF);
    int par = 0;
    for (int qi = 0; qi < 2; ++qi) { const int q = qi ? qb : qa; if (q < 0) continue;
        unsigned* ctr = ctl + CW_Q + 64 * q; const int lo = q_lo(q), hi = q_hi(q);
        if (tid == 0) { const unsigned d = xb_ld(done); CL[par] = d ? -1 : (int)xb_add(ctr, 16u); }
        __syncthreads();
        int base = __builtin_amdgcn_readfirstlane(CL[par]); par ^= 1;
        for (;;) {
            if (base < 0) return;
            if (base + lo >= hi) break;
            const int it = base + lo + 2 * wave; const bool v0 = it < hi, v1 = it + 1 < hi;
            unsigned dn = 0; if (tid == 0) dn = xb_ld(done);
            asm volatile("" ::: "memory");
            const CItem c0 = conv_decode(F, a, v0 ? it : lo), c1 = conv_decode(F, a, v1 ? it + 1 : lo);
            float t0[64], t1[64];
            if (v0) conv_load(c0, t0, lane); if (v1) conv_load(c1, t1, lane);
            asm volatile("" ::: "memory");
            if (tid == 0) CL[par] = dn ? -1 : (int)xb_add(ctr, 16u);
            if (v0) conv_store<true>(c0, t0, scr, lane); if (v1) conv_store<true>(c1, t1, scr, lane);
            __syncthreads();
            base = __builtin_amdgcn_readfirstlane(CL[par]); par ^= 1; } }
}
__device__ __forceinline__ void weight_rest(const Frame& F, const Args& a, int q) {
    PHASE_IDS;
    __syncthreads();
    const int lo = q_lo(q), hi = q_hi(q); const unsigned got = xb_ld((unsigned*)(F.ws + WS_CTL) + CW_Q + 64 * q);
    const int P = __builtin_amdgcn_readfirstlane(lo + (int)(got < (unsigned)(hi - lo) ? got : (unsigned)(hi - lo)));
    LAS bf16* scr = (LAS bf16*)(F.lds + RING_OFF + 8192 + wave * 8704);
    conv_items(F, a, P, hi, hi, hi, F.bid * NWAVES + wave, F.G * NWAVES, scr, lane);
}
#ifndef NCV_G1
#define NCV_G1 96
#endif
#ifndef NCV_G3
#define NCV_G3 16
#endif
__device__ __forceinline__ void p0_prologue(const Frame& F, const Args& a) {
    PHASE_IDS;
    const int gw = F.bid * NWAVES + wave, NGW = F.G * NWAVES;
    { LAS float* SC = (LAS float*)(F.lds + RING_OFF + 81920);
        const float* cvec = a.in[1]; const float* ada_w = a.in[17]; float* PART = (float*)(F.ws + WS_PART);
        for (int i = tid; i < 4 * D; i += NTHR) SC[i] = siluf_(cvec[i]);
        __syncthreads();
        for (int it = gw; it < 2 * 16 * (D6 / 64); it += NGW) { const int l = it / (16 * (D6 / 64)), rem = it % (16 * (D6 / 64)), kr = rem / (D6 / 64), cg = rem % (D6 / 64);
            const float* w = ada_w + (size_t)l * D * D6 + (size_t)(128 * kr) * D6 + cg * 64 + lane; const LAS float* sc = SC + 128 * kr;
            float a0 = 0.f, a1 = 0.f, a2 = 0.f, a3 = 0.f;
#pragma unroll 32
            for (int k = 0; k < 128; ++k) { const float wv = __builtin_nontemporal_load(w + (size_t)k * D6); a0 += sc[k] * wv; a1 += sc[D + k] * wv; a2 += sc[2 * D + k] * wv; a3 += sc[3 * D + k] * wv; }
            float* pp = PART + ((size_t)(l * 16 + kr) * 4) * D6 + cg * 64 + lane; pp[0] = a0; pp[D6] = a1; pp[2 * (size_t)D6] = a2; pp[3 * (size_t)D6] = a3; } }
    LAS bf16* scr = (LAS bf16*)(F.lds + RING_OFF + 8192 + wave * 8704);
    conv_items(F, a, IR_IN0, IR_IN1, IR_IN1, IR_IN1, gw, NGW, scr, lane);
    conv_items(F, a, IR_MIX, NITEMS, NITEMS, NITEMS, gw, NGW, scr, lane);
}

__device__ __forceinline__ void stage_w8(int tid, const float* __restrict__ src, int ld, LAS float* dst) {
    for (int d = tid; d < D; d += NTHR) { const f32x4 w0 = *(const f32x4*)(src + (size_t)d * ld), w1 = *(const f32x4*)(src + (size_t)d * ld + 4);
        dst[0 * D + d] = w0.x; dst[1 * D + d] = w0.y; dst[2 * D + d] = w0.z; dst[3 * D + d] = w0.w; dst[4 * D + d] = w1.x; dst[5 * D + d] = w1.y; dst[6 * D + d] = w1.z; dst[7 * D + d] = w1.w; }
}
__device__ __forceinline__ void dots8(const f32x4 (&u)[8], const LAS float* wt, int lane, float (&acc)[8]) {
#pragma unroll
    for (int e = 0; e < 8; ++e) { float s = 0.f;
#pragma unroll
        for (int j = 0; j < 8; ++j) { const f32x4 w = *(const LAS f32x4*)(wt + e * D + 4 * lane + 256 * j); s += u[j].x * w.x + u[j].y * w.y + u[j].z * w.z + u[j].w * w.w; }
        acc[e] = wave_sum(s); asm volatile("" ::: "memory"); }
}
__device__ __forceinline__ void store_u_bf16(bf16* urow, const f32x4 (&u)[8], int lane) {
#pragma unroll
    for (int j = 0; j < 8; ++j) { v2u o; o.x = pk2(u[j].x, u[j].y); o.y = pk2(u[j].z, u[j].w); *(v2u*)(urow + 4 * lane + 256 * j) = o; }
}
__device__ __forceinline__ void modulate(f32x4 (&u)[8], const f32x4 (&x)[8], const float* __restrict__ sh, const float* __restrict__ sc, int lane) {
#pragma unroll
    for (int j = 0; j < 8; ++j) { const f32x4 s = *(const f32x4*)(sc + 4 * lane + 256 * j), h = *(const f32x4*)(sh + 4 * lane + 256 * j); u[j] = x[j] * (s + 1.0f) + h; }
}
__device__ __forceinline__ void ln_row(f32x4 (&v)[8], const float* __restrict__ lw, const float* __restrict__ lb, int lane, float& mean_o, float& rs_o) {
    float s = 0.f;
#pragma unroll
    for (int j = 0; j < 8; ++j) s += (v[j].x + v[j].y) + (v[j].z + v[j].w);
    const float mean = wave_sum(s) * (1.f / D); float q = 0.f;
#pragma unroll
    for (int j = 0; j < 8; ++j) { v[j] = v[j] - mean; q += (v[j].x * v[j].x + v[j].y * v[j].y) + (v[j].z * v[j].z + v[j].w * v[j].w); }
    const float rs = rsqrtf(wave_sum(q) * (1.f / D) + EPS); mean_o = mean; rs_o = rs;
#pragma unroll
    for (int j = 0; j < 8; ++j) { const f32x4 w = *(const f32x4*)(lw + 4 * lane + 256 * j), b = *(const f32x4*)(lb + 4 * lane + 256 * j); v[j] = v[j] * rs * w + b; }
}
__device__ __forceinline__ void ln_center(f32x4 (&v)[8], float& mean_o, float& rs_o) {
    float s = 0.f;
#pragma unroll
    for (int j = 0; j < 8; ++j) s += (v[j].x + v[j].y) + (v[j].z + v[j].w);
    const float mean = wave_sum(s) * (1.f / D); float q = 0.f;
#pragma unroll
    for (int j = 0; j < 8; ++j) { v[j] = v[j] - mean; q += (v[j].x * v[j].x + v[j].y * v[j].y) + (v[j].z * v[j].z + v[j].w * v[j].w); }
    mean_o = mean; rs_o = rsqrtf(wave_sum(q) * (1.f / D) + EPS);
}
__device__ __forceinline__ void stage_ab(int tid, const float* __restrict__ lw, const float* __restrict__ lb, const float* __restrict__ sh, const float* __restrict__ sc, LAS float* AV, LAS float* BV) {
    for (int d = tid * 4; d < D; d += NTHR * 4) { const f32x4 w = *(const f32x4*)(lw + d), b = *(const f32x4*)(lb + d), h = *(const f32x4*)(sh + d), c = *(const f32x4*)(sc + d) + 1.0f;
        *(LAS f32x4*)(AV + d) = w * c; *(LAS f32x4*)(BV + d) = b * c + h; }
}
__device__ __forceinline__ void row_init(const Frame& F, const Args& a) {
    PHASE_IDS;
    LAS float* wt = (LAS float*)(F.lds + RING_OFF); LAS float* ML = (LAS float*)(F.lds + RING_OFF + 65536);
    stage_w8(tid, a.in[2] + 2048, INC, wt);
    const float* PART = (const float*)(F.ws + WS_PART); const float* ada_b = a.in[18]; float* ADAw = (float*)(F.ws + WS_ADA);
    for (int idx = F.bid * NTHR + tid; idx < 2 * 4 * D6; idx += F.G * NTHR) { const int l = idx / (4 * D6), b = (idx / D6) % 4, col = idx % D6; float s = ada_b[l * D6 + col];
#pragma unroll
        for (int kr = 0; kr < 16; ++kr) s += PART[((size_t)(l * 16 + kr) * 4 + b) * D6 + col];
        ADAw[idx] = s; }
    bf16* U = (bf16*)(F.ws + WS_U); float* GT = (float*)(F.ws + WS_GATES);
    for (int ch = F.bid; ch < M / 32; ch += F.G) {
        { const int b = (ch * 32) / SEQ;
            for (int j = tid; j < 2 * D; j += NTHR) { float s = ada_b[j];
#pragma unroll
                for (int kr = 0; kr < 16; ++kr) s += PART[((size_t)kr * 4 + b) * D6 + j];
                ML[j] = s; } }
        __syncthreads();
    for (int i2 = 0; i2 < 4; i2 += 2) { f32x4 xx[2][8];
#pragma unroll
        for (int i = 0; i < 2; ++i)
#pragma unroll
            for (int j = 0; j < 8; ++j) xx[i][j] = *(const f32x4*)(a.in[0] + (size_t)(ch * 32 + wave * 4 + i2 + i) * D + 4 * lane + 256 * j);
#pragma unroll
        for (int i = 0; i < 2; ++i) { const int m = ch * 32 + wave * 4 + i2 + i;
            f32x4 x[8], u[8];
#pragma unroll
            for (int j = 0; j < 8; ++j) x[j] = xx[i][j];
#pragma unroll
            for (int j = 0; j < 8; ++j) { const f32x4 s = *(const LAS f32x4*)(ML + D + 4 * lane + 256 * j), hh = *(const LAS f32x4*)(ML + 4 * lane + 256 * j); u[j] = x[j] * (s + 1.0f) + hh; }
            store_u_bf16(U + (size_t)m * D, u, lane);
            float g[8]; dots8(u, wt, lane, g);
            if (lane == 0) { *(f32x4*)(GT + (size_t)m * 8) = (f32x4){g[0], g[1], g[2], g[3]}; *(f32x4*)(GT + (size_t)m * 8 + 4) = (f32x4){g[4], g[5], g[6], g[7]}; } } }
        __syncthreads(); }
}
__device__ __forceinline__ void row_ln1(const Frame& F, const Args& a, int l) {
    PHASE_IDS;
    LAS float* wt = (LAS float*)(F.lds + RING_OFF); LAS int* se = (LAS int*)(F.lds + RING_OFF + 65536); LAS float* AV = (LAS float*)(F.lds + RING_OFF + 66560); LAS float* BV = AV + D;
    const bool moe = (l == 1);
    if (moe) { stage_w8(tid, a.in[26], 8, wt); __syncthreads(); }
    const float* adal = (const float*)(F.ws + WS_ADA) + (size_t)l * 4 * D6; bf16* U = (bf16*)(F.ws + WS_U); float* X = (float*)(F.ws + WS_X); const bf16* T = (const bf16*)(F.ws + WS_T);
    int* tok_e = (int*)(F.ws + WS_TOKE); float* tok_w = (float*)(F.ws + WS_TOKW); int* cnt = (int*)(F.ws + WS_CNT);
    if (moe) { int* rtok = (int*)(F.ws + WS_RTOK); for (int i = F.bid * NTHR + tid; i < PAIRROWS; i += F.G * NTHR) rtok[i] = 0; }
    for (int ch = F.bid; ch < M / 32; ch += F.G) {
        { const float* adab = adal + (size_t)((ch * 32) / SEQ) * D6; stage_ab(tid, a.in[19] + l * D, a.in[20] + l * D, adab + 3 * D, adab + 4 * D, AV, BV); }
        __syncthreads();
        for (int i2 = 0; i2 < 4; i2 += 2) { f32x4 vv[2][8];
#pragma unroll
        for (int i = 0; i < 2; ++i)
#pragma unroll
            for (int j = 0; j < 8; ++j) { const v2u tw = *(const v2u*)(T + (size_t)(ch * 32 + wave * 4 + i2 + i) * D + 4 * lane + 256 * j); vv[i][j] = (f32x4){bflo(tw.x), bfhi(tw.x), bflo(tw.y), bfhi(tw.y)}; }
#pragma unroll
        for (int i = 0; i < 2; ++i) { const int tl = wave * 4 + i2 + i, m = ch * 32 + tl;
            f32x4 v[8], u[8];
#pragma unroll
            for (int j = 0; j < 8; ++j) v[j] = vv[i][j];
            float mean_, rs_; ln_center(v, mean_, rs_);
            if (lane == 0) { X[2 * (size_t)m] = mean_; X[2 * (size_t)m + 1] = rs_; }
#pragma unroll
            for (int j = 0; j < 8; ++j) u[j] = v[j] * rs_ * *(const LAS f32x4*)(AV + 4 * lane + 256 * j) + *(const LAS f32x4*)(BV + 4 * lane + 256 * j);
            store_u_bf16(U + (size_t)m * D, u, lane);
            if (moe) { float lg[8]; dots8(u, wt, lane, lg);
#pragma unroll
                for (int e = 0; e < 8; ++e) lg[e] += a.in[27][e];
                int i1 = 0; float v1 = lg[0];
#pragma unroll
                for (int e = 1; e < 8; ++e) if (lg[e] > v1) { v1 = lg[e]; i1 = e; }
                int i2 = -1; float v2 = -3.0e38f;
#pragma unroll
                for (int e = 0; e < 8; ++e) if (e != i1 && lg[e] > v2) { v2 = lg[e]; i2 = e; }
                if (i2 < 0) i2 = (i1 + 1) & 7;
                const float e2 = __expf(v2 - v1), w1 = rcpf_(1.f + e2), w2 = e2 * w1;
                if (lane == 0) { tok_e[m * 2] = i1; tok_e[m * 2 + 1] = i2; tok_w[m * 2] = w1; tok_w[m * 2 + 1] = w2; se[tl * 2] = i1; se[tl * 2 + 1] = i2; } } } }
        if (moe) { __syncthreads();
            if (tid < 8) { int c = 0; for (int t = 0; t < 32; ++t) c += (se[t * 2] == tid) + (se[t * 2 + 1] == tid); cnt[ch * 8 + tid] = c; } }
        __syncthreads(); }
}
__device__ __forceinline__ void moe_scatter(const Frame& F) {
    PHASE_IDS;
    LAS int* sh = (LAS int*)(F.lds + RING_OFF);
    const int* tok_e = (const int*)(F.ws + WS_TOKE); const int* cnt = (const int*)(F.ws + WS_CNT); int* ppos = (int*)(F.ws + WS_PPOS); int* pane = (int*)(F.ws + WS_PANE);
    int* rtok = (int*)(F.ws + WS_RTOK);
    for (int ch = F.bid; ch < M / 32; ch += F.G) {
        int tot = 0, before = 0;
        { const int e = tid & 7, sgm = tid >> 3; int pt = 0, pb = 0;
#pragma unroll
            for (int q = 0; q < 4; ++q) { const int c = sgm * 4 + q; const int v = cnt[c * 8 + e]; pt += v; if (c < ch) pb += v; }
            sh[128 + tid] = pt; sh[128 + NTHR + tid] = pb; }
        __syncthreads();
        if (tid < 8) { for (int s2 = 0; s2 < 64; ++s2) { tot += sh[128 + s2 * 8 + tid]; before += sh[128 + NTHR + s2 * 8 + tid]; } sh[tid] = tot; }
        __syncthreads();
        if (tid < 8) { int start = 0; for (int e = 0; e < tid; ++e) start += (sh[e] + 255) / 256 * 256;
            sh[8 + tid] = start + before;
            if (ch == 0) { const int p0 = start / 256, np = (tot + 255) / 256; for (int p = 0; p < np; ++p) pane[p0 + p] = tid;
                if (tid == 7) { for (int p = p0 + np; p < MAXPANEL; ++p) pane[p] = 0; pane[MAXPANEL] = p0 + np; } } }
        __syncthreads();
        if (tid >= 64 && tid < 128) sh[1300 + tid - 64] = tok_e[ch * 64 + tid - 64];
        __syncthreads();
        if (tid < 8) { int base = sh[8 + tid]; for (int pr = 0; pr < 64; ++pr) if (sh[1300 + pr] == tid) sh[16 + pr] = base++; }
        __syncthreads();
        if (tid < 64) { ppos[ch * 64 + tid] = sh[16 + tid]; rtok[sh[16 + tid]] = ch * 32 + (tid >> 1); }
        __syncthreads(); }
}
__device__ __forceinline__ void row_ln2(const Frame& F, const Args& a, int l) {
    PHASE_IDS;
    LAS float* wt = (LAS float*)(F.lds + RING_OFF); LAS float* AV = (LAS float*)(F.lds + RING_OFF + 66560); LAS float* BV = AV + D;
    if (l == 0) { stage_w8(tid, a.in[2] + (size_t)D * INC + 2048, INC, wt); __syncthreads(); }
    const float* adal = (const float*)(F.ws + WS_ADA) + (size_t)l * 4 * D6; const float* adan = adal + 4 * D6;
    bf16* U = (bf16*)(F.ws + WS_U); float* X = (float*)(F.ws + WS_X); const bf16* T = (const bf16*)(F.ws + WS_T); float* GT = (float*)(F.ws + WS_GATES);
    const int* ppos = (const int*)(F.ws + WS_PPOS); const float* tok_w = (const float*)(F.ws + WS_TOKW); const bf16* YP = (const bf16*)(F.ws + WS_PROJ);
    for (int ch = F.bid; ch < M / 32; ch += F.G) {
        if (l == 0) { __syncthreads(); { const float* adab = adan + (size_t)((ch * 32) / SEQ) * D6; stage_ab(tid, a.in[21] + l * D, a.in[22] + l * D, adab, adab + D, AV, BV); }
            __syncthreads();
            for (int i2 = 0; i2 < 4; i2 += 2) { f32x4 vv[2][8];
#pragma unroll
            for (int i = 0; i < 2; ++i)
#pragma unroll
                for (int j = 0; j < 8; ++j) { const v2u tw = *(const v2u*)(T + (size_t)(ch * 32 + wave * 4 + i2 + i) * D + 4 * lane + 256 * j); vv[i][j] = (f32x4){bflo(tw.x), bfhi(tw.x), bflo(tw.y), bfhi(tw.y)}; }
#pragma unroll
            for (int i = 0; i < 2; ++i) { const int m = ch * 32 + wave * 4 + i2 + i, b = m / SEQ; f32x4 v[8], u[8];
#pragma unroll
                for (int j = 0; j < 8; ++j) v[j] = vv[i][j];
                float mean_, rs_; ln_center(v, mean_, rs_);
                if (lane == 0) { X[2 * (size_t)m] = mean_; X[2 * (size_t)m + 1] = rs_; }
#pragma unroll
                for (int j = 0; j < 8; ++j) u[j] = v[j] * rs_ * *(const LAS f32x4*)(AV + 4 * lane + 256 * j) + *(const LAS f32x4*)(BV + 4 * lane + 256 * j);
                store_u_bf16(U + (size_t)m * D, u, lane);
                float g[8]; dots8(u, wt, lane, g);
                if (lane == 0) { *(f32x4*)(GT + (size_t)m * 8) = (f32x4){g[0], g[1], g[2], g[3]}; *(f32x4*)(GT + (size_t)m * 8 + 4) = (f32x4){g[4], g[5], g[6], g[7]}; } } }
        } else {
            LAS float* PV = (LAS float*)(F.lds + RING_OFF);
            __syncthreads();
            { const float* g2 = adal + (size_t)((ch * 32) / SEQ) * D6 + 5 * D;
                for (int d = tid * 4; d < D; d += NTHR * 4) { *(LAS f32x4*)(PV + d) = *(const f32x4*)(a.in[19] + l * D + d) * ALPHA; *(LAS f32x4*)(PV + D + d) = *(const f32x4*)(a.in[20] + l * D + d) * ALPHA;
                    *(LAS f32x4*)(PV + 2 * D + d) = *(const f32x4*)(g2 + d) + 1.0f; *(LAS f32x4*)(PV + 3 * D + d) = *(const f32x4*)(a.in[21] + l * D + d); *(LAS f32x4*)(PV + 4 * D + d) = *(const f32x4*)(a.in[22] + l * D + d); } }
            __syncthreads();
            for (int i2 = 0; i2 < 4; i2 += 2) { f32x4 xx[2][8]; v2u ya[2][8], yb[2][8]; float w1[2], w2[2];
#pragma unroll
                for (int i = 0; i < 2; ++i) { const int m = ch * 32 + wave * 4 + i2 + i; const int p1 = ppos[m * 2], p2 = ppos[m * 2 + 1]; w1[i] = tok_w[m * 2]; w2[i] = tok_w[m * 2 + 1];
#pragma unroll
                    for (int j = 0; j < 8; ++j) { const int d = 4 * lane + 256 * j; const v2u tw = *(const v2u*)(T + (size_t)m * D + d); xx[i][j] = (f32x4){bflo(tw.x), bfhi(tw.x), bflo(tw.y), bfhi(tw.y)}; ya[i][j] = *(const v2u*)(YP + (size_t)p1 * D + d); yb[i][j] = *(const v2u*)(YP + (size_t)p2 * D + d); } }
#pragma unroll
                for (int i = 0; i < 2; ++i) { const int m = ch * 32 + wave * 4 + i2 + i; f32x4 v[8]; const float mu1 = X[2 * (size_t)m], rs1 = X[2 * (size_t)m + 1];
#pragma unroll
                    for (int j = 0; j < 8; ++j) { const int d = 4 * lane + 256 * j; const v2u y1 = ya[i][j], y2 = yb[i][j];
                        f32x4 y; y.x = w1[i] * __uint_as_float(y1.x << 16) + w2[i] * __uint_as_float(y2.x << 16); y.y = w1[i] * __uint_as_float(y1.x & 0xffff0000u) + w2[i] * __uint_as_float(y2.x & 0xffff0000u);
                        y.z = w1[i] * __uint_as_float(y1.y << 16) + w2[i] * __uint_as_float(y2.y << 16); y.w = w1[i] * __uint_as_float(y1.y & 0xffff0000u) + w2[i] * __uint_as_float(y2.y & 0xffff0000u);
                        v[j] = (xx[i][j] - mu1) * rs1 * *(const LAS f32x4*)(PV + d) + *(const LAS f32x4*)(PV + D + d) + *(const LAS f32x4*)(PV + 2 * D + d) * y;
                        asm volatile("" ::: "memory"); }
                    float mean_, rs_; ln_center(v, mean_, rs_);
#pragma unroll
                    for (int j = 0; j < 8; ++j) { const int d = 4 * lane + 256 * j; *(f32x4*)(a.out + (size_t)m * D + d) = v[j] * rs_ * *(const LAS f32x4*)(PV + 3 * D + d) + *(const LAS f32x4*)(PV + 4 * D + d);
                        if (j & 1) asm volatile("" ::: "memory"); } } } } }
    __syncthreads();
}
typedef float f32x16 __attribute__((ext_vector_type(16)));
typedef short s16x8 __attribute__((ext_vector_type(8)));
__device__ __forceinline__ int crow(int r, int hi) { return (r & 3) + 8 * (r >> 2) + 4 * hi; }
__device__ __forceinline__ s16x8 ld8(const LAS bf16* p) { return *(const LAS s16x8*)p; }
__device__ __forceinline__ s16x8 ld8g(const bf16* p) { return *(const s16x8*)p; }
template <int K> __device__ __forceinline__ void mma_ll(f32x16& acc, const LAS bf16* A, int lda, const LAS bf16* B, int ldb, int lane) {
    const int r = lane & 31, ko = 8 * (lane >> 5);
#pragma unroll
    for (int k = 0; k < K; k += 16) acc = __builtin_amdgcn_mfma_f32_32x32x16_bf16(ld8(A + r * lda + k + ko), ld8(B + r * ldb + k + ko), acc, 0, 0, 0);
}
__device__ __forceinline__ int swz(int row, int s) { return (((s >> 3) ^ ((row >> 3) & 7)) << 3) | (s & 7); }
template <int K, bool SWA, bool SWB> __device__ __forceinline__ void mma_ll_sw(f32x16& acc, const LAS bf16* A, int lda, int rowA0, const LAS bf16* B, int ldb, int rowB0, int lane) {
    const int r = lane & 31, hi = lane >> 5, ra = rowA0 + r, rb = rowB0 + r;
#pragma unroll
    for (int k = 0; k < K; k += 16) { const int g = (k >> 3) + hi;
        const int ca = SWA ? ((g ^ ((ra >> 3) & 7)) << 3) : (g << 3), cb = SWB ? ((g ^ ((rb >> 3) & 7)) << 3) : (g << 3);
        acc = __builtin_amdgcn_mfma_f32_32x32x16_bf16(ld8(A + ra * lda + ca), ld8(B + rb * ldb + cb), acc, 0, 0, 0); }
}
template <int K> __device__ __forceinline__ void mma_lg(f32x16& acc, const LAS bf16* A, int lda, const bf16* B, int ldb, int lane) {
    const int r = lane & 31, ko = 8 * (lane >> 5);
#pragma unroll
    for (int k = 0; k < K; k += 16) acc = __builtin_amdgcn_mfma_f32_32x32x16_bf16(ld8(A + r * lda + k + ko), ld8g(B + (size_t)r * ldb + k + ko), acc, 0, 0, 0);
}
template <int K> __device__ __forceinline__ void mma_gg(f32x16& acc, const bf16* A, int lda, const bf16* B, int ldb, int lane) {
    const int r = lane & 31, ko = 8 * (lane >> 5);
#pragma unroll
    for (int k = 0; k < K; k += 16) acc = __builtin_amdgcn_mfma_f32_32x32x16_bf16(ld8g(A + (size_t)r * lda + k + ko), ld8g(B + (size_t)r * ldb + k + ko), acc, 0, 0, 0);
}
__device__ __forceinline__ f32x16 zero16() { f32x16 z;
#pragma unroll
    for (int i = 0; i < 16; ++i) z[i] = 0.f; return z; }
__device__ __forceinline__ void rms_tile_to_ycat(const LAS float* Y, const float* __restrict__ gw, bf16* __restrict__ YCAT, int m0, int coff, int wave, int lane) {
    for (int i = 0; i < 4; ++i) { const int t = wave * 4 + i; const f32x4 v0 = *(const LAS f32x4*)(Y + t * 512 + lane * 8), v1 = *(const LAS f32x4*)(Y + t * 512 + lane * 8 + 4);
        const float ss = (v0.x * v0.x + v0.y * v0.y) + (v0.z * v0.z + v0.w * v0.w) + (v1.x * v1.x + v1.y * v1.y) + (v1.z * v1.z + v1.w * v1.w);
        const float rs = rsqrtf(wave_sum(ss) * (1.f / 512.f) + EPS);
        const f32x4 g0 = *(const f32x4*)(gw + lane * 8), g1 = *(const f32x4*)(gw + lane * 8 + 4);
        v4u o; o.x = pk2(v0.x * rs * g0.x, v0.y * rs * g0.y); o.y = pk2(v0.z * rs * g0.z, v0.w * rs * g0.w); o.z = pk2(v1.x * rs * g1.x, v1.y * rs * g1.y); o.w = pk2(v1.z * rs * g1.z, v1.w * rs * g1.w);
        *(v4u*)(YCAT + (size_t)(m0 + t) * D + coff + lane * 8) = o; }
}
__device__ __forceinline__ void mix_conv(const Frame& F, const Args& a, int l, int tile) {
    PHASE_IDS;
    const int m0 = tile * 32, t0 = m0 % SEQ;
    LAS bf16* HI = (LAS bf16*)(F.lds);
    LAS float* CV = (LAS float*)(F.lds + 63488);
    LAS bf16* CL = (LAS bf16*)(F.lds);
    const bf16* PROJ = (const bf16*)(F.ws + WS_PROJ); bf16* YCAT = (bf16*)(F.ws + WS_YCAT);
    float w[31]; const float dwb = a.in[10][l * GW + tid];
    { const float* dw = a.in[9] + (size_t)l * 31 * GW + tid;
#pragma unroll
        for (int j = 0; j < 31; ++j) w[j] = dw[j * GW]; }
#pragma unroll
    for (int it = 0; it < 8; ++it) { const int i = tid + it * NTHR; if (i >= 62 * 64) break; const int tt = i >> 6, c8 = (i & 63) * 8;
        v4u o = (v4u){0u, 0u, 0u, 0u};
        if (t0 - 30 + tt >= 0) { const bf16* p = PROJ + (size_t)(m0 - 30 + tt) * PC + C_CONV + c8; const v4u av = *(const v4u*)p, gv = *(const v4u*)(p + 512);
#pragma unroll
            for (int j = 0; j < 4; ++j) o[j] = pk2(bflo(av[j]) * sigmoidf_(bflo(gv[j])), bfhi(av[j]) * sigmoidf_(bfhi(gv[j]))); }
        *(LAS v4u*)(HI + tt * 512 + c8) = o; }
    __syncthreads();
    { const int c = tid; float acc[32]; const float bias = dwb;
#pragma unroll
        for (int t = 0; t < 32; ++t) acc[t] = bias;
#pragma unroll
        for (int tt = 0; tt < 62; ++tt) { const float hv = bf2f(HI[tt * 512 + c]);
#pragma unroll
            for (int t = 0; t < 32; ++t) { const int j = tt - t; if (j >= 0 && j <= 30) acc[t] += w[j] * hv; } }
#pragma unroll
        for (int t = 0; t < 32; ++t) CV[t * 512 + c] = acc[t]; }
    __syncthreads();
    { const float* lw = a.in[11] + l * GW + lane * 8; const float* lb = a.in[12] + l * GW + lane * 8;
        for (int i = 0; i < 4; ++i) { const int t = wave * 4 + i; f32x4 v0 = *(const LAS f32x4*)(CV + t * 512 + lane * 8), v1 = *(const LAS f32x4*)(CV + t * 512 + lane * 8 + 4);
            const float mean = wave_sum((v0.x + v0.y) + (v0.z + v0.w) + (v1.x + v1.y) + (v1.z + v1.w)) * (1.f / 512.f); v0 = v0 - mean; v1 = v1 - mean;
            const float rs = rsqrtf(wave_sum((v0.x * v0.x + v0.y * v0.y) + (v0.z * v0.z + v0.w * v0.w) + (v1.x * v1.x + v1.y * v1.y) + (v1.z * v1.z + v1.w * v1.w)) * (1.f / 512.f) + EPS);
            const f32x4 w0 = *(const f32x4*)lw, w1 = *(const f32x4*)(lw + 4), b0 = *(const f32x4*)lb, b1 = *(const f32x4*)(lb + 4);
            v0 = v0 * rs * w0 + b0; v1 = v1 * rs * w1 + b1;
            v4u o; o.x = pk2(siluf_(v0.x), siluf_(v0.y)); o.y = pk2(siluf_(v0.z), siluf_(v0.w)); o.z = pk2(siluf_(v1.x), siluf_(v1.y)); o.w = pk2(siluf_(v1.z), siluf_(v1.w));
            *(LAS v4u*)(CL + t * 520 + lane * 8) = o; } }
    __syncthreads();
    { const bf16* PWT = (const bf16*)(F.ws + WS_PWT) + (size_t)l * GW * GW; const int hi = lane >> 5, r = lane & 31;
        LAS bf16* BS = (LAS bf16*)(F.lds + 33280);
        v4u pre[8]; f32x16 acc[2]; acc[0] = zero16(); acc[1] = zero16();
        const int krot = F.bid & 7;
#pragma unroll
        for (int q = 0; q < 8; ++q) { const int p = tid + NTHR * q; pre[q] = *(const v4u*)(PWT + (size_t)(p >> 3) * GW + 64 * krot + 8 * (p & 7)); }
        for (int kc0 = 0; kc0 < 8; ++kc0) { const int kc = (kc0 + krot) & 7, kn = (kc0 + 1 + krot) & 7;
#pragma unroll
            for (int q = 0; q < 8; ++q) { const int p = tid + NTHR * q; *(LAS v4u*)(BS + (p >> 3) * 72 + 8 * (p & 7)) = pre[q]; }
            __syncthreads();
            if (kc0 < 7) {
#pragma unroll
                for (int q = 0; q < 8; ++q) { const int p = tid + NTHR * q; pre[q] = *(const v4u*)(PWT + (size_t)(p >> 3) * GW + 64 * kn + 8 * (p & 7)); } }
#pragma unroll
            for (int q = 0; q < 2; ++q)
#pragma unroll
                for (int kk = 0; kk < 4; ++kk) acc[q] = __builtin_amdgcn_mfma_f32_32x32x16_bf16(ld8(CL + r * 520 + 64 * kc + 16 * kk + 8 * hi), ld8(BS + ((wave * 2 + q) * 32 + r) * 72 + 16 * kk + 8 * hi), acc[q], 0, 0, 0);
            __syncthreads(); }
#pragma unroll
        for (int q = 0; q < 2; ++q) { const int n = (wave * 2 + q) * 32 + r; const float bv = a.in[14][l * GW + n];
#pragma unroll
            for (int rr = 0; rr < 16; ++rr) CV[crow(rr, hi) * 512 + n] = acc[q][rr] + bv; } }
    __syncthreads();
    rms_tile_to_ycat(CV, a.in[15] + l * 3 * GW + 2 * GW, YCAT, m0, 1536, wave, lane);
    __syncthreads();
}
__device__ __forceinline__ void mix_pool(const Frame& F, const Args& a, int l, int tile) {
    PHASE_IDS;
    const int m0 = tile * 32, t0 = m0 % SEQ;
    LAS bf16* PI = (LAS bf16*)(F.lds);
    LAS float* YB = (LAS float*)(F.lds + 33280);
    const bf16* PROJ = (const bf16*)(F.ws + WS_PROJ); bf16* YCAT = (bf16*)(F.ws + WS_YCAT);
    const bf16* PLT = (const bf16*)(F.ws + WS_PLT) + (size_t)l * 4 * 128 * 128; s16x8 wfr[2][8]; float psc[2];
#pragma unroll
    for (int q = 0; q < 2; ++q) { const int idx = wave * 2 + q, g = idx >> 2, nb = idx & 3; psc[q] = a.in[8][l * GW + g * 128 + nb * 32 + (lane & 31)];
#pragma unroll
        for (int k = 0; k < 8; ++k) wfr[q][k] = ld8g(PLT + ((size_t)g * 128 + nb * 32 + (lane & 31)) * 128 + 16 * k + 8 * (lane >> 5)); }
    LAS bf16* RAW = (LAS bf16*)(F.lds + 33280);
#pragma unroll
    for (int it = 0; it < 6; ++it) { const int i = tid + it * NTHR; if (i >= 47 * 64) break; const int rr = i >> 6, c8 = (i & 63) * 8;
        if (t0 - 15 + rr >= 0) *(LAS v4u*)(RAW + rr * 512 + c8) = *(const v4u*)(PROJ + (size_t)(m0 - 15 + rr) * PC + C_POOL + c8); }
    __syncthreads();
    for (int i = tid; i < 32 * 64; i += NTHR) { const int t = i >> 6, c8 = (i & 63) * 8, g = c8 >> 7, win = 2 << g; const int ta = t0 + t; const int n = (ta + 1 < win) ? ta + 1 : win;
        float s[8], cur[8];
#pragma unroll
        for (int j = 0; j < 8; ++j) { s[j] = 0.f; cur[j] = 0.f; }
#pragma unroll
        for (int j = 0; j < 16; ++j) { v4u rv = (v4u){0u, 0u, 0u, 0u}; if (j < n) rv = *(const LAS v4u*)(RAW + (15 + t - j) * 512 + c8);
#pragma unroll
            for (int q = 0; q < 4; ++q) { s[2 * q] += bflo(rv[q]); s[2 * q + 1] += bfhi(rv[q]); if (j == 0) { cur[2 * q] = bflo(rv[q]); cur[2 * q + 1] = bfhi(rv[q]); } } }
        const float inv = rcpf_((float)n); v4u o;
#pragma unroll
        for (int q = 0; q < 4; ++q) o[q] = pk2(s[2 * q] * inv - cur[2 * q], s[2 * q + 1] * inv - cur[2 * q + 1]);
        *(LAS v4u*)(PI + t * 520 + c8) = o; }
    __syncthreads();
    { const int hi = lane >> 5;
#pragma unroll
        for (int q = 0; q < 2; ++q) { const int idx = wave * 2 + q, g = idx >> 2, nb = idx & 3; f32x16 acc = zero16();
#pragma unroll
            for (int k = 0; k < 8; ++k) acc = __builtin_amdgcn_mfma_f32_32x32x16_bf16(ld8(PI + (lane & 31) * 520 + g * 128 + 16 * k + 8 * hi), wfr[q][k], acc, 0, 0, 0);
            const int n = g * 128 + nb * 32 + (lane & 31);
#pragma unroll
            for (int r = 0; r < 16; ++r) YB[crow(r, hi) * 512 + n] = acc[r] * psc[q]; } }
    __syncthreads();
    rms_tile_to_ycat(YB, a.in[15] + l * 3 * GW, YCAT, m0, 512, wave, lane);
    __syncthreads();
}
__device__ __forceinline__ void mix_sb_unit(const Frame& F, const Args& a, int l, LAS unsigned char* wl, int unit, int dh, int wave, int lane) {
    const int qb = unit & 63, bh = unit >> 6, b = bh >> 2, h = bh & 3; const int mq = b * SEQ + qb * 32, hi = lane >> 5, t = lane & 31;
    LAS bf16* VT = (LAS bf16*)wl;
    const bf16* PROJ = (const bf16*)(F.ws + WS_PROJ); bf16* YCAT = (bf16*)(F.ws + WS_YCAT);
    const bf16* Qp = PROJ + (size_t)(mq + t) * PC + C_SB + h * 128 + 8 * hi;
    s16x8 qf[8];
#pragma unroll
    for (int k = 0; k < 8; ++k) qf[k] = ld8g(Qp + 16 * k);
    f32x16 O[2]; O[0] = zero16(); O[1] = zero16();
    float P = 1.f;
    for (int kb = qb; kb >= 0; --kb) {
        const bf16* Kp = PROJ + (size_t)(b * SEQ + kb * 32) * PC + C_SB + 512 + h * 128; const bf16* Vp = Kp + 512 + dh * 64;
        f32x16 S = zero16();
#pragma unroll
        for (int k = 0; k < 8; ++k) S = __builtin_amdgcn_mfma_f32_32x32x16_bf16(ld8g(Kp + (size_t)t * PC + 16 * k + 8 * hi), qf[k], S, 0, 0, 0);
#pragma unroll
        for (int i = 0; i < 4; ++i) { const int idx = lane + 64 * i, s = idx >> 3, d8 = (idx & 7) * 8; const v4u vv = *(const v4u*)(Vp + (size_t)s * PC + d8);
#pragma unroll
            for (int q = 0; q < 4; ++q) { const int d0 = d8 + 2 * q, c0 = (((s >> 3) ^ ((d0 >> 3) & 3)) << 3) | (s & 7);
                VT[d0 * 40 + c0] = (bf16)(vv[q] & 0xffffu); VT[(d0 + 1) * 40 + c0] = (bf16)(vv[q] >> 16); } }
        float beta[16], keep[16];
#pragma unroll
        for (int r = 0; r < 16; ++r) { const bool valid = (kb < qb) || (crow(r, hi) < t);
            const float z = fminf(fmaxf(S[r] * 0.088388347648318447f, -80.f), 80.f); const float e = __expf(-z), bt = rcpf_(1.f + e);
            beta[r] = valid ? bt : 0.f; keep[r] = valid ? e * bt : 1.f; }
        float gp[4], pg[4];
#pragma unroll
        for (int j = 0; j < 4; ++j) { gp[j] = (keep[4 * j] * keep[4 * j + 1]) * (keep[4 * j + 2] * keep[4 * j + 3]); pg[j] = __shfl_xor(gp[j], 32); }
        float so[4], sp[4]; so[3] = 1.f; so[2] = gp[3]; so[1] = gp[3] * gp[2]; so[0] = so[1] * gp[1];
        sp[3] = 1.f; sp[2] = pg[3]; sp[1] = pg[3] * pg[2]; sp[0] = sp[1] * pg[1];
        float av[16];
#pragma unroll
        for (int j = 0; j < 4; ++j) { const float ga = P * so[j] * (hi ? sp[j] : sp[j] * pg[j]);
            const float k3 = keep[4 * j + 3], k23 = k3 * keep[4 * j + 2], k123 = k23 * keep[4 * j + 1];
            av[4 * j + 3] = beta[4 * j + 3] * ga; av[4 * j + 2] = beta[4 * j + 2] * ga * k3; av[4 * j + 1] = beta[4 * j + 1] * ga * k23; av[4 * j] = beta[4 * j] * ga * k123; }
        P = P * (so[0] * gp[0]) * (sp[0] * pg[0]);
        s16x8 pb[2];
#pragma unroll
        for (int s2 = 0; s2 < 2; ++s2) { v4u w; w.x = pk2(av[8 * s2], av[8 * s2 + 1]); w.y = pk2(av[8 * s2 + 2], av[8 * s2 + 3]); w.z = pk2(av[8 * s2 + 4], av[8 * s2 + 5]); w.w = pk2(av[8 * s2 + 6], av[8 * s2 + 7]);
            pb[s2] = __builtin_bit_cast(s16x8, w); }
        LDS_WAIT();
#pragma unroll
        for (int db = 0; db < 2; ++db)
#pragma unroll
            for (int s2 = 0; s2 < 2; ++s2) { const int dr = db * 32 + t, key = (dr >> 3) & 3; const LAS bf16* vrow = VT + dr * 40 + 4 * hi;
                const v2u lo = *(const LAS v2u*)(vrow + (((2 * s2) ^ key) << 3)), hi2 = *(const LAS v2u*)(vrow + (((2 * s2 + 1) ^ key) << 3)); v4u w; w.x = lo.x; w.y = lo.y; w.z = hi2.x; w.w = hi2.y;
                O[db] = __builtin_amdgcn_mfma_f32_32x32x16_bf16(__builtin_bit_cast(s16x8, w), pb[s2], O[db], 0, 0, 0); }
        LDS_WAIT();
        if (wave_max(P) < 1e-12f) break;
    }
    LAS float* SSQ = (LAS float*)(F.lds + 65536);
    float ss = 0.f;
#pragma unroll
    for (int db = 0; db < 2; ++db)
#pragma unroll
        for (int r = 0; r < 16; ++r) ss += O[db][r] * O[db][r];
    ss += __shfl_xor(ss, 32);
    if (hi == 0) SSQ[wave * 32 + t] = ss;
    __syncthreads();
    float tot = 0.f;
#pragma unroll
    for (int w8 = 0; w8 < 8; ++w8) tot += SSQ[w8 * 32 + t];
    const float rs = rsqrtf(tot * (1.f / 512.f) + EPS);
    const float* gw = a.in[15] + l * 3 * GW + GW + h * 128 + dh * 64 + 4 * hi;
#pragma unroll
    for (int db = 0; db < 2; ++db)
#pragma unroll
        for (int g4 = 0; g4 < 4; ++g4) { const f32x4 g = *(const f32x4*)(gw + db * 32 + 8 * g4);
            v2u o; o.x = pk2(O[db][4 * g4] * rs * g.x, O[db][4 * g4 + 1] * rs * g.y); o.y = pk2(O[db][4 * g4 + 2] * rs * g.z, O[db][4 * g4 + 3] * rs * g.w);
            *(v2u*)(YCAT + (size_t)(mq + t) * D + 1024 + h * 128 + dh * 64 + db * 32 + 8 * g4 + 4 * hi) = o; }
    __syncthreads();
}
__device__ __forceinline__ void conv4_silu8(const bf16* PROJ, int m, int t, int ch, const float* __restrict__ cw, const float* __restrict__ cb, float (&o)[8]) {
    const f32x4 b0 = *(const f32x4*)(cb + ch), b1 = *(const f32x4*)(cb + ch + 4);
    o[0] = b0.x; o[1] = b0.y; o[2] = b0.z; o[3] = b0.w; o[4] = b1.x; o[5] = b1.y; o[6] = b1.z; o[7] = b1.w;
#pragma unroll
    for (int j = 0; j < 4; ++j) if (t - 3 + j >= 0) { const v4u pv = *(const v4u*)(PROJ + (size_t)(m - 3 + j) * PC + C_QK + ch);
        const f32x4 w0 = *(const f32x4*)(cw + j * 1024 + ch), w1 = *(const f32x4*)(cw + j * 1024 + ch + 4);
        o[0] += w0.x * bflo(pv[0]); o[1] += w0.y * bfhi(pv[0]); o[2] += w0.z * bflo(pv[1]); o[3] += w0.w * bfhi(pv[1]);
        o[4] += w1.x * bflo(pv[2]); o[5] += w1.y * bfhi(pv[2]); o[6] += w1.z * bflo(pv[3]); o[7] += w1.w * bfhi(pv[3]); }
#pragma unroll
    for (int j = 0; j < 8; ++j) o[j] = siluf_(o[j]);
}
constexpr size_t WSM_DC = WS_NAIVE + (size_t)M * GW * 2;
constexpr size_t WSM_CS = WSM_DC + (size_t)NUNIT * STATE * 4;
constexpr size_t WSM_GA = WSM_CS + (size_t)NUNIT * STATE * 2;
constexpr size_t WSM_MS = WSM_GA + 4096;
constexpr size_t WSM_BB = WSM_MS + 4096;
constexpr size_t WSM_AL = WSM_BB + (size_t)NBH * SEQ * 4;
constexpr size_t WSM_END = WSM_AL + (size_t)NBH * SEQ * 4;
__device__ __forceinline__ void mix_mlstm_a(const Frame& F, const Args& a, int l, int unit) {
    PHASE_IDS;
    LAS bf16* KWT = (LAS bf16*)(F.lds);
    LAS bf16* VT = (LAS bf16*)(F.lds + 18432);
    LAS float* sw = (LAS float*)(F.lds + 36864);
    const int bh = unit / NCHUNK, c = unit % NCHUNK, b = bh >> 2, h = bh & 3, t0 = c * CH, m0 = b * SEQ + t0;
    const bf16* PROJ = (const bf16*)(F.ws + WS_PROJ); const float* GT = (const float*)(F.ws + WS_GATES);
    float* DC = (float*)(F.ws + WSM_DC) + (size_t)unit * STATE; float* GA = (float*)(F.ws + WSM_GA); float* BB = (float*)(F.ws + WSM_BB); float* AL = (float*)(F.ws + WSM_AL);
    if (wave == 0) { const float* gb = a.in[5] + l * 8;
        const float ip = GT[(size_t)(m0 + lane) * 8 + h] + gb[h], fp = GT[(size_t)(m0 + lane) * 8 + 4 + h] + gb[4 + h];
        float lf = logsigmoidf_(fp);
#pragma unroll
        for (int o = 1; o < 64; o <<= 1) { const float n = __shfl_up(lf, o); if (lane >= o) lf += n; }
        const float g = __shfl(lf, 63), av = g - lf + ip, amax = wave_max(av);
        sw[lane] = __expf(av - amax); BB[(size_t)bh * SEQ + t0 + lane] = lf; AL[(size_t)bh * SEQ + t0 + lane] = ip - lf;
        if (lane == 0) { GA[unit * 2] = g; GA[unit * 2 + 1] = amax; } }
    __syncthreads();
    const float* cw = a.in[3] + l * 4 * 1024; const float* cb = a.in[4] + l * 1024;
#pragma unroll
    for (int i = tid; i < 64 * 16; i += NTHR) { const int s = i >> 4, d8 = (i & 15) * 8; float kv[8];
        conv4_silu8(PROJ, m0 + s, t0 + s, 512 + h * 128 + d8, cw, cb, kv); const float w = sw[s];
        const v4u vv = *(const v4u*)(PROJ + (size_t)(m0 + s) * PC + C_V + h * 128 + d8);
#pragma unroll
        for (int j = 0; j < 8; ++j) KWT[(d8 + j) * 72 + swz(d8 + j, s)] = (bf16)f2bf(kv[j] * w);
#pragma unroll
        for (int q = 0; q < 4; ++q) { VT[(d8 + 2 * q) * 72 + swz(d8 + 2 * q, s)] = (bf16)(vv[q] & 0xffffu); VT[(d8 + 2 * q + 1) * 72 + swz(d8 + 2 * q + 1, s)] = (bf16)(vv[q] >> 16); } }
    __syncthreads();
    { const int hi = lane >> 5;
        for (int q = 0; q < 2; ++q) { const int idx = wave * 2 + q, eb = idx >> 2, nb = idx & 3; f32x16 acc = zero16();
            mma_ll_sw<64, true, true>(acc, VT, 72, eb * 32, KWT, 72, nb * 32, lane);
#pragma unroll
            for (int r = 0; r < 16; ++r) DC[(eb * 32 + crow(r, hi)) * 128 + nb * 32 + (lane & 31)] = acc[r]; } }
    if (tid < 128) { float s = 0.f; for (int j = 0; j < 64; ++j) s += bf2f(KWT[tid * 72 + j]); DC[128 * 128 + tid] = s; }
    __syncthreads();
}
__device__ __forceinline__ void mix_scan(const Frame& F) {
    PHASE_IDS;
    const float* DC = (const float*)(F.ws + WSM_DC); const float* GA = (const float*)(F.ws + WSM_GA); bf16* CS = (bf16*)(F.ws + WSM_CS); float* MS = (float*)(F.ws + WSM_MS);
    LAS float* TB = (LAS float*)(F.lds + RING_OFF);
    if (tid < NBH) { const int bh = tid; float gg[NCHUNK], am[NCHUNK];
#pragma unroll
        for (int c = 0; c < NCHUNK; ++c) { gg[c] = GA[(bh * NCHUNK + c) * 2]; am[c] = GA[(bh * NCHUNK + c) * 2 + 1]; }
        float m = 0.f;
#pragma unroll
        for (int c = 0; c < NCHUNK; ++c) { if (F.bid == 0) MS[bh * NCHUNK + c] = m;
            const float mn = fmaxf(gg[c] + m, am[c]); TB[(bh * NCHUNK + c) * 2] = __expf(gg[c] + m - mn); TB[(bh * NCHUNK + c) * 2 + 1] = __expf(am[c] - mn); m = mn; } }
    __syncthreads();
    const int N = F.G * NTHR, total = NBH * STATE, gt = F.bid * NTHR + tid;
    const int R = total % (2 * N), nfull = total / (2 * N);
    const bool spread = (R > 0 && R <= 8 * F.G && nfull > 0);
    for (int base = 0; base < total; base += 2 * N) {
        if (spread && base + 2 * N > total) break;
        const int i0 = base + gt, i1 = base + N + gt; const bool v0 = i0 < total, v1 = i1 < total;
        if (base + F.bid * NTHR >= total) break;
        const int b0 = v0 ? i0 / STATE : 0, x0 = v0 ? i0 % STATE : 0, b1 = v1 ? i1 / STATE : 0, x1 = v1 ? i1 % STATE : 0;
        const int i2 = total - R + F.bid * 8 + tid; const bool v2 = spread && base == 0 && tid < 8 && i2 < total; const int b2 = v2 ? i2 / STATE : 0, x2 = v2 ? i2 % STATE : 0;
        float d0[NCHUNK], d1[NCHUNK];
#pragma unroll
        for (int c = 0; c < NCHUNK; ++c) { d0[c] = DC[(size_t)(b0 * NCHUNK + c) * STATE + x0]; d1[c] = DC[(size_t)(b1 * NCHUNK + c) * STATE + x1]; }
        if (spread && base == 0 && wave == 0) {
            float d2[NCHUNK];
#pragma unroll
            for (int c = 0; c < NCHUNK; ++c) d2[c] = DC[(size_t)(b2 * NCHUNK + c) * STATE + x2];
            float C2 = 0.f;
#pragma unroll
            for (int c = 0; c < NCHUNK; ++c) { if (v2) CS[(size_t)(b2 * NCHUNK + c) * STATE + x2] = (bf16)f2bf(C2); C2 = TB[(b2 * NCHUNK + c) * 2] * C2 + TB[(b2 * NCHUNK + c) * 2 + 1] * d2[c]; } }
        float C0 = 0.f, C1 = 0.f;
#pragma unroll
        for (int c = 0; c < NCHUNK; ++c) {
            if (v0) CS[(size_t)(b0 * NCHUNK + c) * STATE + x0] = (bf16)f2bf(C0);
            if (v1) CS[(size_t)(b1 * NCHUNK + c) * STATE + x1] = (bf16)f2bf(C1);
            C0 = TB[(b0 * NCHUNK + c) * 2] * C0 + TB[(b0 * NCHUNK + c) * 2 + 1] * d0[c];
            C1 = TB[(b1 * NCHUNK + c) * 2] * C1 + TB[(b1 * NCHUNK + c) * 2 + 1] * d1[c]; } }
    __syncthreads();
}
__device__ __forceinline__ void mix_mlstm_c(const Frame& F, const Args& a, int l, int unit) {
    PHASE_IDS;
    LAS bf16* QI = (LAS bf16*)(F.lds);
    LAS bf16* KI = (LAS bf16*)(F.lds + 17408);
    LAS bf16* VT = (LAS bf16*)(F.lds + 34816);
    LAS bf16* WI = (LAS bf16*)(F.lds + 53248);
    LAS float* HB = (LAS float*)(F.lds + 62464);
    LAS float* al = (LAS float*)(F.lds + 96256); LAS float* mu = al + 64; LAS float* inter = mu + 64; LAS float* flo = inter + 64;
    const int bh = unit / NCHUNK, c = unit % NCHUNK, b = bh >> 2, h = bh & 3, t0 = c * CH, m0 = b * SEQ + t0, hi = lane >> 5;
    const bf16* PROJ = (const bf16*)(F.ws + WS_PROJ); bf16* YCAT = (bf16*)(F.ws + WS_YCAT);
    const bf16* Cs = (const bf16*)(F.ws + WSM_CS) + (size_t)unit * STATE; const float mst = ((const float*)(F.ws + WSM_MS))[unit];
    if (wave == 0) { const float av = ((const float*)(F.ws + WSM_AL))[(size_t)bh * SEQ + t0 + lane]; al[lane] = av; float pm = av;
#pragma unroll
        for (int o = 1; o < 64; o <<= 1) { const float n = __shfl_up(pm, o); if (lane >= o) pm = fmaxf(pm, n); }
        const float m_ = fmaxf(mst, pm); mu[lane] = m_; inter[lane] = __expf(mst - m_); flo[lane] = __expf(-(((const float*)(F.ws + WSM_BB))[(size_t)bh * SEQ + t0 + lane] + m_)); }
    const int tb_ = wave >> 2, eb_ = wave & 3; s16x8 cfr[8], nfr[8]; bf16 op0[8], op1[8];
#pragma unroll
    for (int k = 0; k < 8; ++k) { cfr[k] = ld8g(Cs + (size_t)(eb_ * 32 + (lane & 31)) * 128 + 16 * k + 8 * hi); nfr[k] = ld8g(Cs + 128 * 128 + 16 * k + 8 * hi); }
#pragma unroll
    for (int i = 0; i < 8; ++i) { const size_t m = m0 + wave * 8 + i; op0[i] = PROJ[m * PC + C_O + h * 128 + lane]; op1[i] = PROJ[m * PC + C_O + h * 128 + 64 + lane]; }
    const float* cw = a.in[3] + l * 4 * 1024; const float* cb = a.in[4] + l * 1024;
#pragma unroll
    for (int i = tid; i < 64 * 32; i += NTHR) { const int s = i >> 5, part = i & 31, isk = part >> 4, d8 = (part & 15) * 8; float o[8];
        conv4_silu8(PROJ, m0 + s, t0 + s, isk * 512 + h * 128 + d8, cw, cb, o); const float sc = isk ? 1.f : 0.088388347648318447f;
        v4u w; w.x = pk2(o[0] * sc, o[1] * sc); w.y = pk2(o[2] * sc, o[3] * sc); w.z = pk2(o[4] * sc, o[5] * sc); w.w = pk2(o[6] * sc, o[7] * sc);
        *(LAS v4u*)((isk ? KI : QI) + s * 136 + d8) = w; }
#pragma unroll
    for (int i = tid; i < 64 * 16; i += NTHR) { const int s = i >> 4, d8 = (i & 15) * 8; const v4u vv = *(const v4u*)(PROJ + (size_t)(m0 + s) * PC + C_V + h * 128 + d8);
#pragma unroll
        for (int q = 0; q < 4; ++q) { VT[(d8 + 2 * q) * 72 + swz(d8 + 2 * q, s)] = (bf16)(vv[q] & 0xffffu); VT[(d8 + 2 * q + 1) * 72 + swz(d8 + 2 * q + 1, s)] = (bf16)(vv[q] >> 16); } }
    __syncthreads();
    if (wave < 4) { const int tb = (wave == 0 || wave == 3) ? 0 : 1, sb = (wave >= 2) ? 1 : 0;
        f32x16 S = zero16(); if (wave != 3) mma_ll<128>(S, QI + tb * 32 * 136, 136, KI + sb * 32 * 136, 136, lane);
        const int s = sb * 32 + (lane & 31); const float as = al[s];
#pragma unroll
        for (int r = 0; r < 16; ++r) { const int t = tb * 32 + crow(r, hi); const float w = (wave != 3 && s <= t) ? __expf(as - mu[t]) * S[r] : 0.f; WI[t * 72 + s] = (bf16)f2bf(w); } }
    __syncthreads();
    { const int tb = tb_, eb = eb_; f32x16 acc = zero16(), den = zero16();
        { const int r_ = lane & 31, ko = 8 * hi;
#pragma unroll
            for (int k = 0; k < 8; ++k) { const s16x8 qa = ld8(QI + (tb * 32 + r_) * 136 + 16 * k + ko);
                acc = __builtin_amdgcn_mfma_f32_32x32x16_bf16(qa, cfr[k], acc, 0, 0, 0); den = __builtin_amdgcn_mfma_f32_32x32x16_bf16(qa, nfr[k], den, 0, 0, 0); } }
#pragma unroll
        for (int r = 0; r < 16; ++r) { const float it = inter[tb * 32 + crow(r, hi)]; acc[r] *= it; den[r] *= it; }
        mma_ll_sw<64, false, true>(acc, WI, 72, tb * 32, VT, 72, eb * 32, lane);
        { const int r_ = lane & 31, ko = 8 * hi; s16x8 ones;
#pragma unroll
            for (int j = 0; j < 8; ++j) ones[j] = (short)0x3f80;
#pragma unroll
            for (int k = 0; k < 64; k += 16) den = __builtin_amdgcn_mfma_f32_32x32x16_bf16(ld8(WI + (tb * 32 + r_) * 72 + k + ko), ones, den, 0, 0, 0); }
#pragma unroll
        for (int r = 0; r < 16; ++r) { const int t = tb * 32 + crow(r, hi); HB[t * 132 + eb * 32 + (lane & 31)] = acc[r] * rcpf_(fmaxf(fabsf(den[r]), flo[t])); } }
    __syncthreads();
    { const float* nw = a.in[6] + l * GW + h * 128; const float nw0 = nw[lane], nw1 = nw[64 + lane];
#pragma unroll
        for (int i = 0; i < 8; ++i) { const int t = wave * 8 + i; const float v0 = HB[t * 132 + lane], v1 = HB[t * 132 + 64 + lane];
            const float mean = wave_sum(v0 + v1) * (1.f / 128.f), d0 = v0 - mean, d1 = v1 - mean; const float rs = rsqrtf(wave_sum(d0 * d0 + d1 * d1) * (1.f / 128.f) + EPS);
            const size_t m = m0 + t;
            YCAT[m * D + h * 128 + lane] = (bf16)f2bf(sigmoidf_(bf2f(op0[i])) * d0 * rs * nw0); YCAT[m * D + h * 128 + 64 + lane] = (bf16)f2bf(sigmoidf_(bf2f(op1[i])) * d1 * rs * nw1); } }
    __syncthreads();
}
__device__ __forceinline__ void mix_sb_norm(const Frame& F, const Args& a, int l) {
    PHASE_IDS;
    const bf16* YCR = (const bf16*)(F.ws + WS_NAIVE); bf16* YCAT = (bf16*)(F.ws + WS_YCAT); const float* gw = a.in[15] + l * 3 * GW + GW + lane * 8;
    for (int m = F.bid * NWAVES + wave; m < M; m += F.G * NWAVES) { const v4u rv = *(const v4u*)(YCR + (size_t)m * GW + lane * 8); float v[8];
#pragma unroll
        for (int q = 0; q < 4; ++q) { v[2 * q] = bflo(rv[q]); v[2 * q + 1] = bfhi(rv[q]); }
        float ss = 0.f;
#pragma unroll
        for (int j = 0; j < 8; ++j) ss += v[j] * v[j];
        const float rs = rsqrtf(wave_sum(ss) * (1.f / 512.f) + EPS); const f32x4 g0 = *(const f32x4*)gw, g1 = *(const f32x4*)(gw + 4);
        v4u o; o.x = pk2(v[0] * rs * g0.x, v[1] * rs * g0.y); o.y = pk2(v[2] * rs * g0.z, v[3] * rs * g0.w); o.z = pk2(v[4] * rs * g1.x, v[5] * rs * g1.y); o.w = pk2(v[6] * rs * g1.z, v[7] * rs * g1.w);
        *(v4u*)(YCAT + (size_t)m * D + 1024 + lane * 8) = o; }
}
#ifndef MIXK
#define MIXK 15
#endif
#ifndef PR_CONV
#define PR_CONV 1
#endif
#ifndef PR_POOL
#define PR_POOL 1
#endif
#ifndef PR_SB
#define PR_SB 1
#endif
#ifndef PR_MA
#define PR_MA 1
#endif
#ifndef PR_MC
#define PR_MC 1
#endif
#ifndef PR_SBN
#define PR_SBN 1
#endif
__device__ __forceinline__ void phase_m1(const Frame& F, const Args& a, int l) {
    for (int tile = F.bid; tile < M / 32; tile += F.G) { if (MIXK & 1) for (int rp = 0; rp < PR_CONV; ++rp) mix_conv(F, a, l, tile); if (MIXK & 2) for (int rp = 0; rp < PR_POOL; ++rp) mix_pool(F, a, l, tile); }
    if (MIXK & 4) { PHASE_IDS; for (int rp = 0; rp < PR_SB; ++rp) for (int q = F.bid; q < BATCH * 64; q += F.G) mix_sb_unit(F, a, l, F.lds + wave * 8192, ((q >> 6) * 4 + (wave >> 1)) * 64 + (q & 63), wave & 1, wave, lane); }
    __syncthreads();
    if (MIXK & 8) for (int rp = 0; rp < PR_MA; ++rp) for (int unit = F.bid; unit < NUNIT; unit += F.G) mix_mlstm_a(F, a, l, unit);
}
__device__ __forceinline__ void phase_m3(const Frame& F, const Args& a, int l) {
    if (MIXK & 8) for (int rp = 0; rp < PR_MC; ++rp) for (int unit = F.bid; unit < NUNIT; unit += F.G) mix_mlstm_c(F, a, l, unit);
}
__global__ void k_mlstm_qk(const bf16* __restrict__ proj, const float* __restrict__ cw, const float* __restrict__ cb, float* __restrict__ QM, float* __restrict__ KM) {
    const size_t i = (size_t)blockIdx.x * 256 + threadIdx.x; const int ch = i % 1024, m = i / 1024, t = m % SEQ;
    float acc = cb[ch];
#pragma unroll
    for (int j = 0; j < 4; ++j) { const int tt = t - 3 + j; if (tt >= 0) acc += cw[j * 1024 + ch] * bf2f(proj[(size_t)(m - 3 + j) * PC + C_QK + ch]); }
    const float v = siluf_(acc);
    if (ch < 512) QM[(size_t)m * GW + ch] = v * 0.088388347648318447f; else KM[(size_t)m * GW + ch - 512] = v;
}
__global__ __launch_bounds__(256) void k_mlstm_a(const bf16* __restrict__ proj, const float* __restrict__ GT, const float* __restrict__ KM, const float* __restrict__ gate_b,
                                                 float* __restrict__ DC, float* __restrict__ GA, float* __restrict__ BB, float* __restrict__ AL) {
    extern __shared__ float sm[];
    float* ks = sm; float* vs = sm + 64 * 128; float* sw = vs + 64 * 128;
    const int unit = blockIdx.x, bh = unit / NCHUNK, c = unit % NCHUNK, b = bh / 4, h = bh % 4, m0 = b * SEQ + c * CH, tid = threadIdx.x;
    if (tid < 64) {
        const float ip = GT[(size_t)(m0 + tid) * 8 + h] + gate_b[h];
        const float fp = GT[(size_t)(m0 + tid) * 8 + 4 + h] + gate_b[4 + h];
        float lf = logsigmoidf_(fp);
#pragma unroll
        for (int o = 1; o < 64; o <<= 1) { const float n = __shfl_up(lf, o); if (tid >= o) lf += n; }
        const float g = __shfl(lf, 63);
        const float a = g - lf + ip;
        const float amax = wave_max(a);
        sw[tid] = __expf(a - amax);
        BB[(size_t)(bh * SEQ + c * CH + tid)] = lf;
        AL[(size_t)(bh * SEQ + c * CH + tid)] = ip - lf;
        if (tid == 0) { GA[unit * 2] = g; GA[unit * 2 + 1] = amax; }
    }
    for (int i = tid; i < 64 * 128; i += 256) { const int s = i / 128, d = i % 128;
        ks[i] = KM[(size_t)(m0 + s) * GW + h * 128 + d]; vs[i] = bf2f(proj[(size_t)(m0 + s) * PC + C_V + h * 128 + d]); }
    __syncthreads();
    float* out = DC + (size_t)unit * STATE;
    for (int o = tid; o < 128 * 128; o += 256) { const int e = o / 128, dk = o % 128; float acc = 0.f;
        for (int s = 0; s < 64; ++s) acc += sw[s] * ks[s * 128 + dk] * vs[s * 128 + e];
        out[o] = acc; }
    if (tid < 128) { float acc = 0.f; for (int s = 0; s < 64; ++s) acc += sw[s] * ks[s * 128 + tid]; out[128 * 128 + tid] = acc; }
}
__global__ void k_mlstm_b(const float* __restrict__ DC, const float* __restrict__ GA, float* __restrict__ CS, float* __restrict__ MS) {
    const int i = blockIdx.x * 256 + threadIdx.x; if (i >= NBH * STATE) return;
    const int bh = i / STATE, idx = i % STATE;
    float m = 0.f, C = 0.f;
    for (int c = 0; c < NCHUNK; ++c) { const int unit = bh * NCHUNK + c;
        CS[(size_t)unit * STATE + idx] = C; if (idx == 0) MS[unit] = m;
        const float g = GA[unit * 2], amax = GA[unit * 2 + 1]; const float mn = fmaxf(g + m, amax);
        C = __expf(g + m - mn) * C + __expf(amax - mn) * DC[(size_t)unit * STATE + idx]; m = mn; }
}
__global__ __launch_bounds__(256) void k_mlstm_c(const bf16* __restrict__ proj, const float* __restrict__ QM, const float* __restrict__ KM, const float* __restrict__ CS,
                                                 const float* __restrict__ MS, const float* __restrict__ BB, const float* __restrict__ AL, const float* __restrict__ norm_w, bf16* __restrict__ YCAT) {
    extern __shared__ float sm[];
    float* qs = sm; float* ks = qs + 64 * 129; float* vs = ks + 64 * 129; float* S = vs + 64 * 128; float* al = S + 64 * 65; float* mu = al + 64; float* den = mu + 64; float* hb = den + 64;
    const int unit = blockIdx.x, bh = unit / NCHUNK, c = unit % NCHUNK, b = bh / 4, h = bh % 4, m0 = b * SEQ + c * CH, tid = threadIdx.x;
    const float mst = MS[unit];
    for (int i = tid; i < 64 * 128; i += 256) { const int s = i / 128, d = i % 128;
        qs[s * 129 + d] = QM[(size_t)(m0 + s) * GW + h * 128 + d]; ks[s * 129 + d] = KM[(size_t)(m0 + s) * GW + h * 128 + d]; vs[i] = bf2f(proj[(size_t)(m0 + s) * PC + C_V + h * 128 + d]); }
    if (tid < 64) { float a = AL[(size_t)bh * SEQ + c * CH + tid]; al[tid] = a;
        float pm = a;
#pragma unroll
        for (int o = 1; o < 64; o <<= 1) { const float n = __shfl_up(pm, o); if (tid >= o) pm = fmaxf(pm, n); }
        mu[tid] = fmaxf(mst, pm); }
    __syncthreads();
    for (int o = tid; o < 64 * 64; o += 256) { const int t = o / 64, s = o % 64; float acc = 0.f;
        if (s <= t) { for (int d = 0; d < 128; ++d) acc += qs[t * 129 + d] * ks[s * 129 + d]; acc *= __expf(al[s] - mu[t]); }
        S[t * 65 + s] = acc; }
    __syncthreads();
    const float* Cst = CS + (size_t)unit * STATE;
    if (tid < 64) { const int t = tid; float qn = 0.f; for (int d = 0; d < 128; ++d) qn += qs[t * 129 + d] * Cst[128 * 128 + d];
        float sw = 0.f; for (int s = 0; s <= t; ++s) sw += S[t * 65 + s];
        const float inter = __expf(mst - mu[t]); const float dn = inter * qn + sw;
        const float bt = BB[(size_t)bh * SEQ + c * CH + t];
        den[t] = fmaxf(fabsf(dn), __expf(-(bt + mu[t]))); }
    __syncthreads();
    for (int o = tid; o < 64 * 128; o += 256) { const int t = o / 128, e = o % 128; float acc = 0.f;
        for (int d = 0; d < 128; ++d) acc += qs[t * 129 + d] * Cst[e * 128 + d];
        acc *= __expf(mst - mu[t]);
        for (int s = 0; s <= t; ++s) acc += S[t * 65 + s] * vs[s * 128 + e];
        hb[t * 129 + e] = acc / den[t]; }
    __syncthreads();
    const int wave = tid / 64, lane = tid % 64;
    for (int t = wave * 16; t < wave * 16 + 16; ++t) {
        const float v0 = hb[t * 129 + lane], v1 = hb[t * 129 + 64 + lane];
        const float mean = wave_sum(v0 + v1) * (1.f / 128.f); const float d0 = v0 - mean, d1 = v1 - mean;
        const float var = wave_sum(d0 * d0 + d1 * d1) * (1.f / 128.f); const float rs = rsqrtf(var + EPS);
        const size_t m = m0 + t;
        const float o0 = bf2f(proj[m * PC + C_O + h * 128 + lane]), o1 = bf2f(proj[m * PC + C_O + h * 128 + 64 + lane]);
        YCAT[m * D + h * 128 + lane] = (bf16)f2bf(sigmoidf_(o0) * d0 * rs * norm_w[h * 128 + lane]);
        YCAT[m * D + h * 128 + 64 + lane] = (bf16)f2bf(sigmoidf_(o1) * d1 * rs * norm_w[h * 128 + 64 + lane]); }
}
__global__ void k_pool1(const bf16* __restrict__ proj, float* __restrict__ P) {
    const size_t i = (size_t)blockIdx.x * 256 + threadIdx.x; const int ch = i % GW, m = i / GW, t = m % SEQ, g = ch / 128, win = 2 << g;
    const int n = (t + 1 < win) ? t + 1 : win; float s = 0.f;
    for (int j = 0; j < n; ++j) s += bf2f(proj[(size_t)(m - j) * PC + C_POOL + ch]);
    P[i] = s / (float)n - bf2f(proj[(size_t)m * PC + C_POOL + ch]);
}
__global__ void k_pool2(const float* __restrict__ P, const float* __restrict__ pw, const float* __restrict__ pscale, float* __restrict__ Y) {
    const size_t i = (size_t)blockIdx.x * 256 + threadIdx.x; const int ch = i % GW, m = i / GW, g = ch / 128, e = ch % 128;
    float acc = 0.f; const float* p = P + (size_t)m * GW + g * 128; const float* w = pw + (size_t)g * 128 * 128 + e;
    for (int c = 0; c < 128; ++c) acc += p[c] * w[c * 128];
    Y[i] = acc * pscale[ch];
}
__global__ void k_rms512(const float* __restrict__ Y, const float* __restrict__ gw, bf16* __restrict__ YCAT, int off) {
    const int m = blockIdx.x * 4 + threadIdx.x / 64, lane = threadIdx.x % 64; float v[8]; float ss = 0.f;
#pragma unroll
    for (int j = 0; j < 8; ++j) { v[j] = Y[(size_t)m * GW + lane + 64 * j]; ss += v[j] * v[j]; }
    const float rs = rsqrtf(wave_sum(ss) * (1.f / 512.f) + EPS);
#pragma unroll
    for (int j = 0; j < 8; ++j) YCAT[(size_t)m * D + off + lane + 64 * j] = (bf16)f2bf(v[j] * rs * gw[lane + 64 * j]);
}
__global__ __launch_bounds__(256) void k_sb(const bf16* __restrict__ proj, float* __restrict__ Y) {
    __shared__ float qsh[4][128];
    const int wave = threadIdx.x / 64, lane = threadIdx.x % 64;
    const int row = blockIdx.x * 4 + wave;
    const int m = row / 4, h = row % 4, t = m % SEQ, mb = m - t;
    const bf16* qp = proj + (size_t)m * PC + C_SB + h * 128;
    qsh[wave][lane] = bf2f(qp[lane]); qsh[wave][lane + 64] = bf2f(qp[lane + 64]);
    __syncthreads();
    float o0 = 0.f, o1 = 0.f, P = 1.f;
    for (int shi = t - 1; shi >= 0 && P > 0.f; shi -= 64) {
        const int s = shi - lane; const bool valid = s >= 0;
        float beta = 0.f, keep = 1.f;
        if (valid) { const bf16* kp = proj + (size_t)(mb + s) * PC + C_SB + 512 + h * 128; float z = 0.f;
            for (int d = 0; d < 128; d += 2) { const unsigned kv = *(const unsigned*)(kp + d); z += qsh[wave][d] * __uint_as_float(kv << 16) + qsh[wave][d + 1] * __uint_as_float(kv & 0xffff0000u); }
            z *= 0.088388347648318447f; z = fminf(fmaxf(z, -80.f), 80.f);
            const float e = __expf(-z); beta = 1.f / (1.f + e); keep = e * beta; }
        float inc = keep;
#pragma unroll
        for (int o = 1; o < 64; o <<= 1) { const float n = __shfl_up(inc, o); if (lane >= o) inc *= n; }
        float exc = __shfl_up(inc, 1); if (lane == 0) exc = 1.f;
        const float a = beta * P * exc;
        P *= __shfl(inc, 63);
        const int nk = (shi + 1 < 64) ? shi + 1 : 64;
        for (int l = 0; l < nk; ++l) { const float al = __shfl(a, l); const bf16* vp = proj + (size_t)(mb + shi - l) * PC + C_SB + 1024 + h * 128;
            o0 += al * bf2f(vp[lane]); o1 += al * bf2f(vp[lane + 64]); }
    }
    Y[(size_t)m * GW + h * 128 + lane] = o0; Y[(size_t)m * GW + h * 128 + lane + 64] = o1;
}
__global__ void k_glu(const bf16* __restrict__ proj, float* __restrict__ Hg) {
    const size_t i = (size_t)blockIdx.x * 256 + threadIdx.x; const int ch = i % GW, m = i / GW;
    Hg[i] = bf2f(proj[(size_t)m * PC + C_CONV + ch]) * sigmoidf_(bf2f(proj[(size_t)m * PC + C_CONV + 512 + ch]));
}
__global__ void k_dwconv(const float* __restrict__ Hg, const float* __restrict__ w, const float* __restrict__ bias, float* __restrict__ CV) {
    const size_t i = (size_t)blockIdx.x * 256 + threadIdx.x; const int ch = i % GW, m = i / GW, t = m % SEQ;
    float acc = bias[ch];
    for (int j = 0; j < 31; ++j) { const int tt = t - 30 + j; if (tt >= 0) acc += w[j * GW + ch] * Hg[(size_t)(m - 30 + j) * GW + ch]; }
    CV[i] = acc;
}
__global__ void k_ln512_silu(const float* __restrict__ CV, const float* __restrict__ lw, const float* __restrict__ lb, float* __restrict__ CL) {
    const int m = blockIdx.x * 4 + threadIdx.x / 64, lane = threadIdx.x % 64; float v[8]; float s = 0.f;
#pragma unroll
    for (int j = 0; j < 8; ++j) { v[j] = CV[(size_t)m * GW + lane + 64 * j]; s += v[j]; }
    const float mean = wave_sum(s) * (1.f / 512.f); float q = 0.f;
#pragma unroll
    for (int j = 0; j < 8; ++j) { v[j] -= mean; q += v[j] * v[j]; }
    const float rs = rsqrtf(wave_sum(q) * (1.f / 512.f) + EPS);
#pragma unroll
    for (int j = 0; j < 8; ++j) { const int c = lane + 64 * j; CL[(size_t)m * GW + c] = siluf_(v[j] * rs * lw[c] + lb[c]); }
}
__global__ void k_pw(const float* __restrict__ A, const float* __restrict__ W, const float* __restrict__ bias, float* __restrict__ Y) {
    __shared__ float as[4][GW];
    const int m0 = blockIdx.x * 4, tid = threadIdx.x;
    for (int i = tid; i < 4 * GW; i += 256) as[i / GW][i % GW] = A[(size_t)(m0 + i / GW) * GW + i % GW];
    __syncthreads();
    for (int n = tid; n < GW; n += 256) { float a0 = 0, a1 = 0, a2 = 0, a3 = 0;
        for (int k = 0; k < GW; ++k) { const float w = W[(size_t)k * GW + n]; a0 += as[0][k] * w; a1 += as[1][k] * w; a2 += as[2][k] * w; a3 += as[3][k] * w; }
        const float bv = bias[n]; Y[(size_t)(m0 + 0) * GW + n] = a0 + bv; Y[(size_t)(m0 + 1) * GW + n] = a1 + bv; Y[(size_t)(m0 + 2) * GW + n] = a2 + bv; Y[(size_t)(m0 + 3) * GW + n] = a3 + bv; }
}
constexpr int NPHASE = 22;
#ifndef PR_P0
#define PR_P0 1
#endif
#ifndef PR_ROW
#define PR_ROW 1
#endif
#ifndef PR_GEMM
#define PR_GEMM 1
#endif
#ifndef PR_MIX
#define PR_MIX 1
#endif
#ifndef PR_SCAN
#define PR_SCAN 1
#endif
#ifndef PR_G
#define PR_G(i) PR_GEMM
#endif
__global__ void __launch_bounds__(NTHR, 2) mega(Args a) {
    extern __shared__ __attribute__((aligned(16))) unsigned char lds[];
    Frame F; F.lds = (LAS unsigned char*)lds; F.G = gridDim.x; F.bid = blockIdx.x; F.ws = a.ws; const int tid = threadIdx.x;
    volatile LAS unsigned* MISC = (volatile LAS unsigned*)(F.lds + MISC_OFF);
    for (int u = tid; u < (LDS_BYTES - LDSCTL_OFF) / 4; u += NTHR) ((LAS unsigned*)(F.lds + LDSCTL_OFF))[u] = 0u;
    __syncthreads();
    XcdBarrier bar = xcd_barrier_post((unsigned*)(a.ws + WS_CTL) + CW_BAR + a.li * XCD_BAR_WORDS, MISC + 8);
    const int lo = a.ph_lo, hi = a.ph_hi;
#define IN(k) (lo <= (k) && (k) < hi)
#define SEAM(k) do { if (IN(k) && IN((k) + 1)) xcd_barrier(bar); } while (0)
    unsigned char* ws = a.ws;
    bf16* U = (bf16*)(ws + WS_U); float* X = (float*)(ws + WS_X); bf16* T = (bf16*)(ws + WS_T); bf16* YCAT = (bf16*)(ws + WS_YCAT); bf16* PROJ = (bf16*)(ws + WS_PROJ); bf16* H = (bf16*)(ws + WS_H);
    const float* ADA = (const float*)(ws + WS_ADA); const int* pane = (const int*)(ws + WS_PANE);
    const int ncv1 = F.G == 256 ? NCV_G1 : 0, ncv3 = F.G == 256 ? NCV_G3 : 0;
    if (IN(0)) for (int rp = 0; rp < PR_P0; ++rp) p0_prologue(F, a);
    SEAM(0);
    if (IN(1)) for (int rp = 0; rp < PR_ROW; ++rp) row_init(F, a);
    SEAM(1);
    for (int l = 0; l < 2; ++l) { const int pb = 2 + 10 * l;
        if (IN(pb + 0)) for (int rp = 0; rp < PR_G(0); ++rp) { const int Gg = F.G - ncv1;
            if (F.bid < Gg) { pg8::Gemm g{U, (const bf16*)(ws + WS_WIN) + (size_t)l * PC * D, M, PC, D}; pg8::StaticOrder S; S.init(M, PC, Gg, F.bid);
                pg8::EpiBf16P E{PROJ, PC, 1 << 20}; pg8::gemm_phase<pg8::EpiBf16P, pg8::StaticOrder, PG8_ALIGN, PG8_SP2>(F.lds + RING_OFF, g, S, E);
                if (ncv1 && ((M / 256) * (PC / 256) - 1) / Gg * Gg + F.bid < (M / 256) * (PC / 256) && otid() == 0) xb_add((unsigned*)(F.ws + WS_CTL) + CW_DONE + 64 * l, 1u); }
            else converter(F, a, l == 0 ? Q_FFN : Q_MOE, l == 0 ? Q_MOE : -1, l); }
        SEAM(pb + 0);
        if (IN(pb + 1)) for (int rp = 0; rp < PR_MIX; ++rp) phase_m1(F, a, l);
        SEAM(pb + 1);
        if (IN(pb + 2) && (MIXK & 8)) for (int rp = 0; rp < PR_MIX * PR_SCAN; ++rp) mix_scan(F);
        SEAM(pb + 2);
        if (IN(pb + 3)) { for (int rp = 0; rp < PR_MIX; ++rp) phase_m3(F, a, l); weight_copies(F, a, IR_OUT0 + l * I_OUT, IR_OUT0 + (l + 1) * I_OUT); }
        SEAM(pb + 3);
        if (IN(pb + 4)) for (int rp = 0; rp < PR_G(1); ++rp) { pg8::Gemm g{YCAT, (const bf16*)(ws + WS_WOUT) + (size_t)l * D * D, M, D, D}; pg8::StaticOrder S; S.init(M, D, F.G, F.bid);
            pg8::EpiResid E{T, l == 0 ? a.in[0] : nullptr, X, a.in[21], a.in[22], ADA + (size_t)l * 4 * D6 + 2 * D};     pg8::gemm_phase<pg8::EpiResid, pg8::StaticOrder, PG8_ALIGN, PG8_SP2>(F.lds + RING_OFF, g, S, E); }
        SEAM(pb + 4);
        if (IN(pb + 5)) { for (int rp = 0; rp < PR_ROW; ++rp) row_ln1(F, a, l); if (l == 0) weight_rest(F, a, Q_FFN); }
        SEAM(pb + 5);
        if (IN(pb + 6) && l == 1) { for (int rp = 0; rp < PR_ROW; ++rp) moe_scatter(F); weight_rest(F, a, Q_MOE); }
        if (l == 1) SEAM(pb + 6);
        if (IN(pb + 7)) for (int rp = 0; rp < PR_G(2); ++rp) {
            if (l == 0) { const int Gg = F.G - ncv3;
                if (F.bid < Gg) { pg8::Gemm g{U, (const bf16*)(ws + WS_WGU), M, 2 * DFF, D}; pg8::StaticOrder S; S.init(M, 2 * DFF, Gg, F.bid);
                    pg8::EpiSwiglu E{H, DFF, 1 << 20}; pg8::gemm_phase<pg8::EpiSwiglu, pg8::StaticOrder, PG8_ALIGN, PG8_SP2>(F.lds + RING_OFF, g, S, E);
                    if (ncv3 && ((M / 256) * (2 * DFF / 256) - 1) / Gg * Gg + F.bid < (M / 256) * (2 * DFF / 256) && otid() == 0) xb_add((unsigned*)(F.ws + WS_CTL) + CW_DONE + 64 * 2, 1u); }
                else converter(F, a, Q_WIN1, Q_MOE, 2); }
            else { const int P = pane[MAXPANEL]; pg8::Gemm g{U, (const bf16*)(ws + WS_MWGU), P * 256, 2 * DFE, D}; pg8::MoeGatherOrder S; S.init(P * 256, 2 * DFE, F.G, F.bid); S.panel_e = pane; S.nNl = 2 * DFE / 256;
                LAS int* IDX = (LAS int*)(F.lds + LDSCTL_OFF + 2048); S.idx = IDX;
                { const int* rtok = (const int*)(ws + WS_RTOK); const int ot = otid();
                    for (int i = 0; i < 8; ++i) { pg8::Unit uu; if (!S.next(i, uu)) break; if (ot < 256) IDX[i * 256 + ot] = rtok[uu.pm * 256 + ot]; }
                    __syncthreads(); }
                pg8::EpiSwiglu E{H, DFE, 2 * DFE / 256}; pg8::gemm_phase<pg8::EpiSwiglu, pg8::MoeGatherOrder, PG8_ALIGN, PG8_SP2>(F.lds + RING_OFF, g, S, E); } }
        SEAM(pb + 7);
        if (IN(pb + 8)) for (int rp = 0; rp < PR_G(3); ++rp) {
            if (l == 0) { pg8::Gemm g{H, (const bf16*)(ws + WS_WD), M, D, DFF}; pg8::StaticOrder S; S.init(M, D, F.G, F.bid);
                pg8::EpiResid E{T, nullptr, X, a.in[19] + l * D, a.in[20] + l * D, ADA + (size_t)l * 4 * D6 + 5 * D}; pg8::gemm_phase<pg8::EpiResid, pg8::StaticOrder, PG8_ALIGN, PG8_SP2>(F.lds + RING_OFF, g, S, E); }
            else { const int P = pane[MAXPANEL]; pg8::Gemm g{H, (const bf16*)(ws + WS_MWD), P * 256, D, DFE}; pg8::MoeOrder S; S.init(P * 256, D, F.G, F.bid); S.panel_e = pane; S.nNl = D / 256;
                pg8::EpiBf16P E{PROJ, D, D / 256}; pg8::gemm_phase<pg8::EpiBf16P, pg8::MoeOrder, PG8_ALIGN, PG8_SP2>(F.lds + RING_OFF, g, S, E); } }
        SEAM(pb + 8);
        if (IN(pb + 9)) { for (int rp = 0; rp < PR_ROW; ++rp) row_ln2(F, a, l); if (l == 0) weight_rest(F, a, Q_WIN1); }
        SEAM(pb + 9);
    }
#undef IN
#undef SEAM
}

extern "C" void kernel_launch(void* const* d_in, const int* in_sizes, int n_in, void* d_out, int out_size, void* d_ws, size_t ws_size, hipStream_t stream) {
    static int grid = 0;
    size_t off = WSM_END; auto alloc = [&](size_t bytes) { void* p = (char*)d_ws + off; off += (bytes + 255) & ~(size_t)255; return p; };
    float* QM = (float*)alloc((size_t)M * GW * 4); float* KM = (float*)alloc((size_t)M * GW * 4);
    float* DC = (float*)alloc((size_t)NUNIT * STATE * 4); float* CS = (float*)alloc((size_t)NUNIT * STATE * 4);
    float* GA = (float*)alloc(NUNIT * 2 * 4); float* MS = (float*)alloc(NUNIT * 4); float* BB = (float*)alloc((size_t)NBH * SEQ * 4); float* AL = (float*)alloc((size_t)NBH * SEQ * 4);
    float* TA = (float*)alloc((size_t)M * GW * 4); float* TB = (float*)alloc((size_t)M * GW * 4);
    if (grid == 0) {
        if (n_in != 31 || out_size != M * D || off > ws_size) { fprintf(stderr, "kernel_launch: unexpected problem (n_in %d out %d) or workspace too small: need %zu have %zu\n", n_in, out_size, off, ws_size); grid = -1; return; }
        int dev = 0, cus = 0, per_cu = 0;
        if (hipGetDevice(&dev) != hipSuccess || hipDeviceGetAttribute(&cus, hipDeviceAttributeMultiprocessorCount, dev) != hipSuccess) { grid = -1; return; }
        if (hipFuncSetAttribute((const void*)mega, hipFuncAttributeMaxDynamicSharedMemorySize, LDS_BYTES) != hipSuccess) { fprintf(stderr, "kernel_launch: hipFuncSetAttribute failed\n"); grid = -1; return; }
        (void)hipFuncSetAttribute((const void*)k_mlstm_a, hipFuncAttributeMaxDynamicSharedMemorySize, 70000); (void)hipFuncSetAttribute((const void*)k_mlstm_c, hipFuncAttributeMaxDynamicSharedMemorySize, 160000);
        if (hipOccupancyMaxActiveBlocksPerMultiprocessor(&per_cu, (const void*)mega, NTHR, LDS_BYTES) != hipSuccess || per_cu < 1) fprintf(stderr, "kernel_launch: occupancy query reports %d blocks per CU\n", per_cu);
        (void)hipGetLastError();
        grid = cus;
    }
    if (grid < 0) return;
    (void)hipMemsetAsync((char*)d_ws + WS_CTL, 0, CTL_ZERO_BYTES, stream);
    Args a{};
    for (int i = 0; i < 31; ++i) a.in[i] = (const float*)d_in[i];
    a.out = (float*)d_out; a.ws = (unsigned char*)d_ws;
    const bf16* PROJ = (const bf16*)((char*)d_ws + WS_PROJ); bf16* YCAT = (bf16*)((char*)d_ws + WS_YCAT); const float* GT = (const float*)((char*)d_ws + WS_GATES);
    int li = 0;
    auto seg = [&](int lo, int hi) { a.ph_lo = lo; a.ph_hi = hi; a.li = li++; hipLaunchKernelGGL(mega, dim3(grid), dim3(NTHR), LDS_BYTES, stream, a); };
    auto mixers = [&](int l) {
        if (!(MIXK & 8)) {
        k_mlstm_qk<<<M * 1024 / 256, 256, 0, stream>>>(PROJ, a.in[3] + l * 4 * 1024, a.in[4] + l * 1024, QM, KM);
        k_mlstm_a<<<NUNIT, 256, (64 * 128 * 2 + 128) * 4, stream>>>(PROJ, GT, KM, a.in[5] + l * 8, DC, GA, BB, AL);
        k_mlstm_b<<<(NBH * STATE + 255) / 256, 256, 0, stream>>>(DC, GA, CS, MS);
        k_mlstm_c<<<NUNIT, 256, (64 * 129 * 3 + 64 * 128 + 64 * 65 + 64 * 3) * 4, stream>>>(PROJ, QM, KM, CS, MS, BB, AL, a.in[6] + l * GW, YCAT); }
        if (!(MIXK & 2)) {
        k_pool1<<<M * GW / 256, 256, 0, stream>>>(PROJ, TA);
        k_pool2<<<M * GW / 256, 256, 0, stream>>>(TA, a.in[7] + (size_t)l * 4 * 128 * 128, a.in[8] + l * GW, TB);
        k_rms512<<<M / 4, 256, 0, stream>>>(TB, a.in[15] + l * 3 * GW, YCAT, 512); }
        if (!(MIXK & 4)) {
        k_sb<<<M, 256, 0, stream>>>(PROJ, TA);
        k_rms512<<<M / 4, 256, 0, stream>>>(TA, a.in[15] + l * 3 * GW + GW, YCAT, 1024); }
        if (!(MIXK & 1)) {
        k_glu<<<M * GW / 256, 256, 0, stream>>>(PROJ, TA);
        k_dwconv<<<M * GW / 256, 256, 0, stream>>>(TA, a.in[9] + (size_t)l * 31 * GW, a.in[10] + l * GW, TB);
        k_ln512_silu<<<M / 4, 256, 0, stream>>>(TB, a.in[11] + l * GW, a.in[12] + l * GW, TA);
        k_pw<<<M / 4, 256, 0, stream>>>(TA, a.in[13] + (size_t)l * GW * GW, a.in[14] + l * GW, TB);
        k_rms512<<<M / 4, 256, 0, stream>>>(TB, a.in[15] + l * 3 * GW + 2 * GW, YCAT, 1536); }
    };
    if (MIXK == 15) seg(0, NPHASE); else { seg(0, 3); mixers(0); seg(3, 13); mixers(1); seg(13, NPHASE); }
}
```
